# Optimizing an MI355X kernel written in HIP

```python
import jax, jax.numpy as jnp
from jax import lax
import numpy as np

D_MODEL = 2048
BATCH = 4
SEQ = 2048
DEPTH = 1

PLE_DIM = 256
HG_HEADS = 8
HG_DK = 128
HG_DV = 128
HG_WIDTH = HG_HEADS * HG_DK
HG_CHUNK = 64
AT_HEADS = 8
AT_HEAD_DIM = 128
AT_WIDTH = AT_HEADS * AT_HEAD_DIM
IDX_HEADS = 16
IDX_DIM = 64
TOPK_MAX = 256
Q_BLOCK = 128
N_GROUPS = 4
EXPERTS_PER_GROUP = 8
N_EXPERTS = N_GROUPS * EXPERTS_PER_GROUP
TOP_K_IN_GROUP = 2
D_EXPERT = 512
RMS_EPS = 1e-6
SPLITS = (HG_WIDTH, HG_WIDTH, HG_HEADS * HG_DV, HG_HEADS * HG_DV,
          AT_WIDTH, AT_WIDTH, AT_WIDTH,
          IDX_HEADS * IDX_DIM, IDX_DIM, IDX_HEADS,
          D_MODEL, D_MODEL)
D_IN = sum(SPLITS)

kernel_name = 'hybrid_hgrn2_dsa_hmoe_block'


def rms_norm(x, g):
    x32 = x.astype(jnp.float32)
    y = x32 * lax.rsqrt(jnp.mean(x32 * x32, axis=-1, keepdims=True) + RMS_EPS)
    return (y * g.astype(jnp.float32)).astype(x.dtype)


def hgrn2_mix(q, f_raw, i, lb):
    B, T, H, DK = q.shape
    DV = i.shape[-1]
    C = HG_CHUNK
    N = T // C
    f32 = jnp.float32
    z = f_raw.astype(f32)
    lb = lb.astype(f32)
    q32 = jax.nn.silu(q.astype(f32))
    logf = jnp.logaddexp(jnp.log(lb), jnp.log1p(-lb) + jax.nn.log_sigmoid(z))
    k32 = (1.0 - lb) * jax.nn.sigmoid(-z)

    def to_chunks(a):
        return a.reshape(B, N, C, H, a.shape[-1]).transpose(1, 0, 3, 2, 4)

    qc, kc, vc, lc = (to_chunks(a) for a in (q32, k32, i.astype(f32), logf))
    bc = jnp.cumsum(lc, axis=3)
    causal = jnp.tril(jnp.ones((C, C), dtype=bool))

    def step(S, inp):
        qn, kn, vn, bn = inp
        rel = bn[:, :, :, None, :] - bn[:, :, None, :, :]
        decay = jnp.exp(jnp.where(causal[:, :, None], rel, -jnp.inf))
        A = jnp.einsum('bhtsd,bhsd->bhts', qn[:, :, :, None, :] * decay, kn)
        o = (jnp.einsum('bhts,bhsv->bhtv', A, vn)
             + jnp.einsum('bhtd,bhdv->bhtv', qn * jnp.exp(bn), S))
        blast = bn[:, :, -1, :]
        S = (jnp.exp(blast)[..., None] * S
             + jnp.einsum('bhsd,bhsv->bhdv', kn * jnp.exp(blast[:, :, None, :] - bn), vn))
        return S, o

    S0 = jnp.zeros((B, H, DK, DV), f32)
    _, o = lax.scan(step, S0, (qc, kc, vc, bc))
    return o.transpose(1, 0, 3, 2, 4).reshape(B, T, H, DV)


def dsa_attention(q, k, v, iq, ik, iw):
    B, T, H, Dh = q.shape
    ksel = min(TOPK_MAX, T // 4)
    nb = T // Q_BLOCK
    f32 = jnp.float32
    scale = Dh ** -0.5
    slopes = jnp.exp2(-8.0 * jnp.arange(1, H + 1, dtype=f32) / H)
    iw = iw.astype(f32) * (IDX_HEADS ** -0.5) * (IDX_DIM ** -0.5)
    ik32 = ik.astype(f32)
    spos = jnp.arange(T, dtype=jnp.int32)

    def blocks(a):
        return a.reshape(B, nb, Q_BLOCK, *a.shape[2:]).swapaxes(0, 1)

    def one_block(inp):
        qb, iqb, iwb, start = inp
        tpos = start + jnp.arange(Q_BLOCK, dtype=jnp.int32)
        rel = jax.nn.relu(jnp.einsum('bthd,bsd->bths', iqb.astype(f32), ik32))
        score = jnp.einsum('bths,bth->bts', rel, iwb)
        visible = spos[None, :] <= tpos[:, None]
        score = jnp.where(visible[None], score, -jnp.inf)
        _, idx = lax.top_k(score, ksel)
        valid = idx <= tpos[None, :, None]
        kg = jax.vmap(lambda kb, ib: kb[ib])(k, idx)
        vg = jax.vmap(lambda vb, ib: vb[ib])(v, idx)
        logits = jnp.einsum('bthd,btkhd->bthk', qb, kg).astype(f32) * scale
        dist = (tpos[None, :, None] - idx).astype(f32)
        logits = logits - slopes[None, None, :, None] * dist[:, :, None, :]
        logits = jnp.where(valid[:, :, None, :], logits, -jnp.inf)
        probs = jax.nn.softmax(logits, axis=-1).astype(vg.dtype)
        return jnp.einsum('bthk,btkhd->bthd', probs, vg)

    starts = jnp.arange(nb, dtype=jnp.int32) * Q_BLOCK
    out = lax.map(one_block, (blocks(q), blocks(iq), blocks(iw), starts))
    return out.swapaxes(0, 1).reshape(B, T, H, Dh)


def hier_moe(h, w_rg, b_rg, w_re, b_re, w_g, w_u, w_d):
    B, T, D = h.shape
    f32 = jnp.float32
    hf = h.reshape(-1, D)
    n = hf.shape[0]
    pg = jax.nn.softmax((hf @ w_rg + b_rg).astype(f32), axis=-1)
    pg_top, gid = lax.top_k(pg, 1)
    elog = (hf @ w_re + b_re).astype(f32).reshape(n, N_GROUPS, EXPERTS_PER_GROUP)
    gidx = jnp.broadcast_to(gid[:, :, None], (n, 1, EXPERTS_PER_GROUP))
    elog_sel = jnp.take_along_axis(elog, gidx, axis=1)[:, 0]
    pe = jax.nn.softmax(elog_sel, axis=-1)
    pe_top, eidx = lax.top_k(pe, TOP_K_IN_GROUP)
    wts = pg_top * pe_top / jnp.sum(pe_top, axis=-1, keepdims=True)
    eid = gid * EXPERTS_PER_GROUP + eidx
    comb = jnp.sum(jax.nn.one_hot(eid, N_EXPERTS, dtype=f32) * wts[..., None], axis=1)
    out = jnp.zeros((n, D), h.dtype)
    for g in range(N_GROUPS):
        sl = slice(g * EXPERTS_PER_GROUP, (g + 1) * EXPERTS_PER_GROUP)
        hid = (jax.nn.silu(jnp.einsum('nd,edf->nef', hf, w_g[sl]))
               * jnp.einsum('nd,edf->nef', hf, w_u[sl]))
        hid = hid * comb[:, sl, None].astype(hid.dtype)
        out = out + jnp.einsum('nef,efd->nd', hid, w_d[sl])
    return out.reshape(B, T, D)


def setup_inputs(seed: int = 0) -> dict:
    key = jax.random.key(seed)
    ks = jax.random.split(key, 24)
    nrm = jax.random.normal
    f32 = jnp.float32
    L = DEPTH
    return {
        'x': nrm(ks[0], (BATCH, SEQ, D_MODEL), f32),
        'p': nrm(ks[1], (DEPTH, BATCH, SEQ, PLE_DIM), f32),
        'attn_norm': 1.0 + 0.02 * nrm(ks[2], (L, D_MODEL), f32),
        'w_in': nrm(ks[3], (L, D_MODEL, D_IN), f32) * D_MODEL ** -0.5,
        'b_in': 0.01 * nrm(ks[4], (L, D_IN), f32),
        'hg_lb_logits': nrm(ks[5], (L + 1, HG_WIDTH), f32),
        'hg_out_norm': 1.0 + 0.02 * nrm(ks[6], (L, HG_DV), f32),
        'w_hg_up': nrm(ks[7], (L, HG_HEADS * HG_DV, D_MODEL), f32) * (HG_HEADS * HG_DV) ** -0.5,
        'w_attn_up': nrm(ks[8], (L, AT_WIDTH, D_MODEL), f32) * AT_WIDTH ** -0.5,
        'w_out': nrm(ks[9], (L, D_MODEL, D_MODEL), f32) * D_MODEL ** -0.5,
        'ffn_norm': 1.0 + 0.02 * nrm(ks[10], (L, D_MODEL), f32),
        'w_router_group': nrm(ks[11], (L, D_MODEL, N_GROUPS), f32) * D_MODEL ** -0.5,
        'b_router_group': 0.01 * nrm(ks[12], (L, N_GROUPS), f32),
        'w_router_expert': nrm(ks[13], (L, D_MODEL, N_EXPERTS), f32) * D_MODEL ** -0.5,
        'b_router_expert': 0.01 * nrm(ks[14], (L, N_EXPERTS), f32),
        'w_exp_gate': nrm(ks[15], (L, N_EXPERTS, D_MODEL, D_EXPERT), f32) * D_MODEL ** -0.5,
        'w_exp_up': nrm(ks[16], (L, N_EXPERTS, D_MODEL, D_EXPERT), f32) * D_MODEL ** -0.5,
        'w_exp_down': nrm(ks[17], (L, N_EXPERTS, D_EXPERT, D_MODEL), f32) * D_EXPERT ** -0.5,
        'ple_norm': 1.0 + 0.02 * nrm(ks[18], (L, D_MODEL), f32),
        'w_ple_gate': nrm(ks[19], (L, D_MODEL, D_MODEL), f32) * D_MODEL ** -0.5,
        'w_ple_proj': nrm(ks[20], (L, PLE_DIM, D_MODEL), f32) * PLE_DIM ** -0.5,
        'final_norm': 1.0 + 0.02 * nrm(ks[21], (D_MODEL,), f32),
    }


def reference(x, p, attn_norm, w_in, b_in, hg_lb_logits, hg_out_norm, w_hg_up, w_attn_up, w_out,
              ffn_norm, w_router_group, b_router_group, w_router_expert, b_router_expert,
              w_exp_gate, w_exp_up, w_exp_down, ple_norm, w_ple_gate, w_ple_proj, final_norm):
    B, T, D = x.shape
    offsets = [int(o) for o in np.cumsum(SPLITS)[:-1]]
    lbs = jnp.cumsum(jax.nn.softmax(hg_lb_logits.astype(jnp.float32), axis=0), axis=0)
    for i in range(DEPTH):
        h = rms_norm(x, attn_norm[i])
        zin = h @ w_in[i] + b_in[i]
        (hq, hf, hi, hgo, aq, ak, av, iq, ik, iw, ga, gb) = jnp.split(zin, offsets, axis=-1)
        o_hg = hgrn2_mix(hq.reshape(B, T, HG_HEADS, HG_DK), hf.reshape(B, T, HG_HEADS, HG_DK),
                         hi.reshape(B, T, HG_HEADS, HG_DV), lbs[i].reshape(HG_HEADS, HG_DK))
        o_hg = rms_norm(o_hg.astype(x.dtype), hg_out_norm[i]) * jax.nn.silu(hgo.reshape(B, T, HG_HEADS, HG_DV))
        y_hg = o_hg.reshape(B, T, HG_HEADS * HG_DV) @ w_hg_up[i]
        o_at = dsa_attention(aq.reshape(B, T, AT_HEADS, AT_HEAD_DIM), ak.reshape(B, T, AT_HEADS, AT_HEAD_DIM),
                             av.reshape(B, T, AT_HEADS, AT_HEAD_DIM), iq.reshape(B, T, IDX_HEADS, IDX_DIM), ik, iw)
        y_at = o_at.reshape(B, T, AT_WIDTH) @ w_attn_up[i]
        mixed = jax.nn.sigmoid(ga) * y_hg + jax.nn.sigmoid(gb) * y_at
        x = x + mixed @ w_out[i]
        x = x + hier_moe(rms_norm(x, ffn_norm[i]), w_router_group[i], b_router_group[i],
                         w_router_expert[i], b_router_expert[i], w_exp_gate[i], w_exp_up[i], w_exp_down[i])
        gate = jax.nn.sigmoid(rms_norm(x, ple_norm[i]) @ w_ple_gate[i])
        x = x + gate * (p[i].astype(x.dtype) @ w_ple_proj[i])
    return rms_norm(x, final_norm)
```

```cpp
#include <hip/hip_runtime.h>
#include <cstdio>
#include <cstdint>

#ifndef N_LAUNCH_MODE
#define N_LAUNCH_MODE 1
#endif
#ifndef STAGE
#define STAGE 99
#endif

#define LAS __attribute__((address_space(3)))
#define GAS __attribute__((address_space(1)))
typedef unsigned short bf16_t;
typedef short bf16x8 __attribute__((ext_vector_type(8)));
typedef short s16x4 __attribute__((ext_vector_type(4)));
typedef float f32x2 __attribute__((ext_vector_type(2)));
typedef float f32x4 __attribute__((ext_vector_type(4)));
typedef float f32x16 __attribute__((ext_vector_type(16)));
typedef unsigned u32x4 __attribute__((ext_vector_type(4)));
typedef unsigned u32x2 __attribute__((ext_vector_type(2)));

constexpr int NB = 4, T = 2048, D = 2048, NTOK = NB * T;
constexpr int HGW = 1024, ATW = 1024;
constexpr int D_IN = 12368;
constexpr int NE = 32, DE = 512, PLE = 256;
constexpr int N1 = 11520;
constexpr float RMS_EPS = 1e-6f;
constexpr int NWAVES = 8, NTHR = 512;
constexpr int MAXTILES = 96;

constexpr size_t MiB = 1u << 20;
constexpr size_t WS_CTL = 0, CTL_ZERO_BYTES = 1 * MiB;
constexpr size_t WS_WHG = 1 * MiB, WS_WAT = 5 * MiB, WS_WOUT = 9 * MiB, WS_WPG = 17 * MiB, WS_WPP = 25 * MiB;
constexpr size_t WS_XN = 26 * MiB;
constexpr size_t WS_PP = 58 * MiB;
constexpr size_t WS_PBF = 90 * MiB;
constexpr size_t WS_MASK = 94 * MiB;
constexpr size_t WS_IK = 96 * MiB;
constexpr size_t WS_IW = 97 * MiB;
constexpr size_t WS_GDEC = 97 * MiB + 512 * 1024;
constexpr size_t WS_ROUTE = 98 * MiB;
constexpr size_t WS_LIST = 99 * MiB;
constexpr size_t WS_RSL = 100 * MiB;
constexpr size_t WS_MISC = 101 * MiB;
constexpr size_t WS_BIG = 102 * MiB;
constexpr size_t WS_WIN = WS_BIG;
constexpr size_t WS_WAV = WS_BIG + 45 * MiB;
constexpr size_t WS_QH = WS_BIG + 49 * MiB, WS_KH = WS_QH + 16 * MiB, WS_VH = WS_KH + 16 * MiB, WS_HGO = WS_VH + 16 * MiB;
constexpr size_t WS_AQ = WS_HGO + 16 * MiB, WS_AK = WS_AQ + 16 * MiB, WS_IQ = WS_AK + 16 * MiB, WS_VT = WS_IQ + 16 * MiB;
constexpr size_t WS_LF = WS_VT + 16 * MiB;
constexpr size_t WS_GAB = WS_LF + 32 * MiB;
constexpr size_t WS_U = WS_GAB + 64 * MiB;
constexpr size_t WS_ST = WS_U + 64 * MiB;
constexpr size_t WS_OHG = WS_ST + 32 * MiB, WS_OAT = WS_OHG + 16 * MiB;
constexpr size_t WS_MIXED = WS_OAT + 16 * MiB;
constexpr size_t WS_END1 = WS_MIXED + 32 * MiB;
constexpr size_t WS_WGU = WS_BIG;
constexpr size_t WS_WD = WS_BIG + 128 * MiB;
constexpr size_t WS_HID = WS_BIG + 192 * MiB;
constexpr size_t WS_Y = WS_BIG + 216 * MiB;
static_assert(WS_Y + 96 * MiB <= WS_MIXED, "late overlays stay below MIXED");
constexpr size_t WS_NEED = WS_END1;

constexpr int CW_CNT = 64;
constexpr int CW_BAR = 4096;

constexpr int RING_BYTES = 131072, LDSCTL_OFF = RING_BYTES, LDS_BYTES = 147456;
constexpr int LC_MISC = LDSCTL_OFF;
constexpr int LC_TEXP = LDSCTL_OFF + 256;
constexpr int LC_TB = LDSCTL_OFF + 256 + 384;
constexpr int LC_CNT = LDSCTL_OFF + 256 + 384 + 144;

struct Params {
    const float *x, *p, *attn_norm, *w_in, *b_in, *lb_logits, *hg_out_norm, *w_hg_up, *w_attn_up, *w_out, *ffn_norm, *w_rg, *b_rg, *w_re, *b_re,
        *w_eg, *w_eu, *w_ed, *ple_norm, *w_pg, *w_pp, *final_norm;
    float* out; unsigned char* ws;
    int ph_lo, ph_hi;
};

__device__ __forceinline__ int tid_from(int wid) { int l = __builtin_amdgcn_mbcnt_hi(~0u, __builtin_amdgcn_mbcnt_lo(~0u, 0u)); asm volatile("" : "+v"(l)); return wid * 64 + l; }
#define opaque_tid() tid_from(WID)
__device__ __forceinline__ unsigned cvt_pk_bf16(float lo, float hi) { unsigned r; asm volatile("v_cvt_pk_bf16_f32 %0, %1, %2" : "=v"(r) : "v"(lo), "v"(hi)); return r; }
__device__ __forceinline__ float bf2f(unsigned short h) { return __uint_as_float((unsigned)h << 16); }
__device__ __forceinline__ float bflo(unsigned w) { return __uint_as_float(w << 16); }
__device__ __forceinline__ float bfhi(unsigned w) { return __uint_as_float(w & 0xffff0000u); }
__device__ __forceinline__ float sigmoid_f(float v) { return __builtin_amdgcn_rcpf(1.0f + __expf(-v)); }
__device__ __forceinline__ float silu_f(float v) { return v * sigmoid_f(v); }
__device__ __forceinline__ float wave_sum(float v) {
#pragma unroll
    for (int o = 1; o < 64; o <<= 1) v += __shfl_xor(v, o);
    return v;
}
#define LDS_WAIT() asm volatile("s_waitcnt lgkmcnt(0)" ::: "memory")
#define VM_WAIT() asm volatile("s_waitcnt vmcnt(0)" ::: "memory")

#define XB_TMO      128
#define XB_XCNT(j)  (256  + 64 * (j))
#define XB_XSUB(j)  (1280 + 64 * (j))
#define XB_XGEN(j)  (2304 + 64 * (j))
#define XB_TOP      3328
#define XB_TOPGEN   3392
#define XCD_BAR_WORDS 3456
#define XB_SPIN_CAP (1u << 18)
__device__ __forceinline__ unsigned xb_ld(unsigned* p)              { return __hip_atomic_load(p, __ATOMIC_RELAXED, __HIP_MEMORY_SCOPE_AGENT); }
__device__ __forceinline__ unsigned xb_add(unsigned* p, unsigned v) { return __hip_atomic_fetch_add(p, v, __ATOMIC_RELAXED, __HIP_MEMORY_SCOPE_AGENT); }
__device__ __forceinline__ unsigned xb_xcc_id() { return (unsigned)__builtin_amdgcn_s_getreg((3 << 11) | 20) & 0xFu; }
#define XB_SPIN(cond, bar) do { unsigned _sp = 0; while (cond) { __builtin_amdgcn_s_sleep(1); \
    if ((++_sp & 255u) == 0u) { if (xb_ld(&(bar)[XB_TMO])) break; if (_sp > XB_SPIN_CAP) { atomicAdd(&(bar)[XB_TMO], 1u); break; } } } } while (0)
struct XcdBarrier { unsigned* bar; unsigned x; volatile LAS unsigned* st; int wid; };
__device__ __forceinline__ XcdBarrier xcd_barrier_post(unsigned* bar, volatile LAS unsigned* st, int WID) {
    XcdBarrier b; b.bar = bar; b.x = xb_xcc_id(); b.st = st; b.wid = WID;
    if (opaque_tid() == 0) (void)xb_add(&bar[XB_XCNT(b.x)], 1u);
    return b;
}
__device__ __forceinline__ void xcd_barrier_complete(unsigned* bar, unsigned x, unsigned& nloc, unsigned& nx) {
    const unsigned G = gridDim.x * gridDim.y * gridDim.z;
    unsigned sum, cnt, mine, sp = 0u;
    for (;;) {
        sum = 0u; cnt = 0u; mine = 0u;
#pragma unroll
        for (unsigned j = 0; j < 16; ++j) { const unsigned c = xb_ld(&bar[XB_XCNT(j)]); sum += c; cnt += (c > 0u) ? 1u : 0u; mine = (j == x) ? c : mine; }
        if (sum == G) break;
        __builtin_amdgcn_s_sleep(1);
        if ((++sp & 255u) == 0u) { if (xb_ld(&bar[XB_TMO])) break; if (sp > XB_SPIN_CAP) { atomicAdd(&bar[XB_TMO], 1u); break; } }
    }
    nloc = mine > 0u ? mine : 1u; nx = cnt > 0u ? cnt : 1u;
}
__device__ __forceinline__ void xcd_barrier(const XcdBarrier& b) {
    asm volatile("s_waitcnt vmcnt(0)" ::: "memory");
    __syncthreads();
    if (tid_from(b.wid) == 0) {
        unsigned* bar = b.bar;
        __builtin_amdgcn_s_waitcnt(0);
        unsigned nloc = b.st[0], nx = b.st[1];
        if (nloc == 0u) { xcd_barrier_complete(bar, b.x, nloc, nx); b.st[0] = nloc; b.st[1] = nx; }
        const unsigned old = xb_add(&bar[XB_XSUB(b.x)], 1u);
        const unsigned gen = old / nloc;
        if (old + 1u == (gen + 1u) * nloc) {
            __builtin_amdgcn_fence(__ATOMIC_RELEASE, "agent");
            asm volatile("s_waitcnt vmcnt(0)" ::: "memory");
            const unsigned og = xb_add(&bar[XB_TOP], 1u);
            const unsigned tg = og / nx;
            if (og + 1u == (tg + 1u) * nx) xb_add(&bar[XB_TOPGEN], 1u);
            else XB_SPIN(xb_ld(&bar[XB_TOPGEN]) == tg, bar);
            __builtin_amdgcn_fence(__ATOMIC_ACQUIRE, "agent");
            xb_add(&bar[XB_XGEN(b.x)], 1u);
            asm volatile("s_waitcnt vmcnt(0)" ::: "memory");
        } else {
            XB_SPIN(xb_ld(&bar[XB_XGEN(b.x)]) == gen, bar);
            __builtin_amdgcn_fence(__ATOMIC_ACQUIRE, "agent");
            asm volatile("s_waitcnt vmcnt(0)" ::: "memory");
        }
    }
    __syncthreads();
}

constexpr int BM = 256, BK = 64, HALF = 128, HTB = HALF * BK * 2;
__device__ __forceinline__ void stage_rc(int b, int& R, int& C) { const int st = b / 1024, sb = b % 1024, swz = sb ^ (((sb >> 9) & 1) << 5); R = (st >> 1) * 16 + swz / 64; C = (st & 1) * 32 + (swz % 64) / 2; }
__device__ __forceinline__ int lds_byte(int r, int c) { const int st = (r >> 4) * 2 + (c >> 5), rr = r & 15, cc = c & 31, ob = rr * 64 + cc * 2; return st * 1024 + (ob ^ (((ob >> 9) & 1) << 5)); }
__device__ __forceinline__ int perm32(int rho) { const int n = rho >> 4, i = rho & 15; return 8 * (i >> 2) + 4 * n + (i & 3); }

enum GemmPhase { GP_INPROJ = 0, GP_MIX = 1, GP_OUT = 2, GP_GU = 3, GP_DN = 4, GP_PLE = 5, GP_PP = 6 };
enum EpiMode { E_SILU = 0, E_HF = 1, E_BF16 = 2, E_AQ = 3, E_SIG = 4, E_IKW = 5, E_VT = 6, E_PP = 7, E_MIX1 = 8, E_MIX2 = 9, E_X1 = 10, E_HID = 11, E_Y = 12, E_PLEG = 13 };

struct GU {
    const char* A; const char* B;
    const int* gidx;
    int lda, ldb;
    int nt;
    int mode, pm, pn, ex, gcnt;
};

__device__ __forceinline__ void map_tile(int L, int nM, int nN, int& pm, int& pn) {
    const int nwg = nM * nN; int wgid = L;
    { const int q = nwg / 8, r = nwg % 8, xcd = wgid % 8, off = wgid / 8; wgid = (xcd < r ? xcd * (q + 1) : r * (q + 1) + (xcd - r) * q) + off; }
    const int nig = 8 * nN, gid = wgid / nig, fm = gid * 8, gsz = (nM - fm) < 8 ? (nM - fm) : 8;
    pm = fm + ((wgid % nig) % gsz); pn = (wgid % nig) / gsz;
}

__device__ __forceinline__ bool unit_next(const Params& P, int ph, int i, int c, int G, const LAS int* lctl, GU& u) {
    unsigned char* ws = P.ws;
    u.gidx = nullptr; u.gcnt = 0; u.ex = 0;
    if (ph == GP_INPROJ) {
        const int L = i * G + c;
        if (L < 1440) {
            map_tile(L, 32, 45, u.pm, u.pn);
            u.A = (const char*)(ws + WS_XN) + (size_t)u.pm * 256 * 4096; u.lda = 4096;
            u.B = (const char*)(ws + WS_WIN) + (size_t)u.pn * 256 * 4096; u.ldb = 4096; u.nt = 32;
            const int pn = u.pn;
            u.mode = pn < 4 ? E_SILU : pn < 8 ? E_HF : pn < 12 ? E_BF16 : pn < 16 ? E_SILU : pn < 20 ? E_AQ : pn < 28 ? E_BF16 : pn < 44 ? E_SIG : E_IKW;
            return true;
        }
        if (L < 1568) {
            const int l = L - 1440; u.pm = l & 3; u.pn = l >> 2;
            u.A = (const char*)(ws + WS_WAV) + (size_t)u.pm * 256 * 4096; u.lda = 4096;
            u.B = (const char*)(ws + WS_XN) + (size_t)u.pn * 256 * 4096; u.ldb = 4096; u.nt = 32; u.mode = E_VT; return true;
        }
        return false;
    }
    if (ph == GP_PP) {
        const int l = i * G + c; if (l >= 256) return false;
        u.pm = l >> 3; u.pn = l & 7;
        u.A = (const char*)(ws + WS_PBF) + (size_t)u.pm * 256 * 512; u.lda = 512;
        u.B = (const char*)(ws + WS_WPP) + (size_t)u.pn * 256 * 512; u.ldb = 512; u.nt = 4; u.mode = E_PP; return true;
    }
    if (ph == GP_MIX) {
        const int tl = (i >> 1) * G + c; if (tl >= 256) return false;
        map_tile(tl, 32, 8, u.pm, u.pn);
        const size_t asrc = (i & 1) ? WS_OAT : WS_OHG, bsrc = (i & 1) ? WS_WAT : WS_WHG;
        u.A = (const char*)(ws + asrc) + (size_t)u.pm * 256 * 2048; u.lda = 2048;
        u.B = (const char*)(ws + bsrc) + (size_t)u.pn * 256 * 2048; u.ldb = 2048; u.nt = 16; u.mode = (i & 1) ? E_MIX2 : E_MIX1; return true;
    }
    if (ph == GP_OUT || ph == GP_PLE) {
        const int L = i * G + c; if (L >= 256) return false;
        map_tile(L, 32, 8, u.pm, u.pn);
        u.A = (const char*)(ws + (ph == GP_OUT ? WS_MIXED : WS_XN)) + (size_t)u.pm * 256 * 4096; u.lda = 4096;
        u.B = (const char*)(ws + (ph == GP_OUT ? WS_WOUT : WS_WPG)) + (size_t)u.pn * 256 * 4096; u.ldb = 4096; u.nt = 32; u.mode = ph == GP_OUT ? E_X1 : E_PLEG; return true;
    }
    if (ph == GP_GU) {
        const int L = i * G + c, ntiles = lctl[(LC_TB - LDSCTL_OFF) / 4 + 32];
        if (L >= ntiles * 4) return false;
        const int tile = L >> 2; u.pn = L & 3; u.pm = tile;
        const int e = lctl[(LC_TEXP - LDSCTL_OFF) / 4 + tile]; u.ex = e;
        const int r0 = (tile - lctl[(LC_TB - LDSCTL_OFF) / 4 + e]) * 256;
        u.gidx = (const int*)(ws + WS_LIST) + e * 8192 + r0; u.gcnt = lctl[(LC_CNT - LDSCTL_OFF) / 4 + e] - r0;
        u.A = (const char*)(ws + WS_XN); u.lda = 4096;
        u.B = (const char*)(ws + WS_WGU) + ((size_t)e * 1024 + (size_t)u.pn * 256) * 4096; u.ldb = 4096; u.nt = 32; u.mode = E_HID; return true;
    }
    if (ph == GP_DN) {
        const int L = i * G + c, ntiles = lctl[(LC_TB - LDSCTL_OFF) / 4 + 32];
        if (L >= ntiles * 8) return false;
        const int tile = L >> 3; u.pn = L & 7; u.pm = tile;
        const int e = lctl[(LC_TEXP - LDSCTL_OFF) / 4 + tile]; u.ex = e;
        u.A = (const char*)(ws + WS_HID) + (size_t)tile * 256 * 1024; u.lda = 1024;
        u.B = (const char*)(ws + WS_WD) + ((size_t)e * 2048 + (size_t)u.pn * 256) * 1024; u.ldb = 1024; u.nt = 8; u.mode = E_Y; return true;
    }
    return false;
}

__device__ __forceinline__ u32x4 pack8(const f32x4 a, const f32x4 b) { u32x4 w; w.x = cvt_pk_bf16(a[0], a[1]); w.y = cvt_pk_bf16(a[2], a[3]); w.z = cvt_pk_bf16(b[0], b[1]); w.w = cvt_pk_bf16(b[2], b[3]); return w; }
__device__ __forceinline__ void unpack8(const u32x4 w, f32x4& a, f32x4& b) { a = (f32x4){bflo(w.x), bfhi(w.x), bflo(w.y), bfhi(w.y)}; b = (f32x4){bflo(w.z), bfhi(w.z), bflo(w.w), bfhi(w.w)}; }

__device__ __forceinline__ bool gemm_epilogue(const Params& P, const GU& u, f32x4 (&acc)[2][2][4][2], int WID) {
    unsigned char* ws = P.ws;
    const int lane_ = opaque_tid() & 63, wr = WID >> 2, wc = WID & 3, fr = lane_ & 15, fq = lane_ >> 4;
    const int rb = u.pm * 256 + wr * 64 + fr;
    const int ct = wc * 32 + 8 * fq;
    const int mode = u.mode;
    if (mode == E_SILU || mode == E_BF16 || mode == E_AQ || mode == E_SIG || mode == E_PP || mode == E_Y) {
        bf16_t* dst; int ldo; const float* bias = nullptr; int cd;
        if (mode == E_PP) { dst = (bf16_t*)(ws + WS_PP); ldo = D; cd = u.pn * 256; }
        else if (mode == E_Y) { dst = (bf16_t*)(ws + WS_Y); ldo = D; cd = u.pn * 256; }
        else {
            const int pn = u.pn; bias = (const float*)(ws + WS_MISC) + pn * 256;
            if (pn < 4) { dst = (bf16_t*)(ws + WS_QH); ldo = 1024; cd = pn * 256; }
            else if (pn < 12) { dst = (bf16_t*)(ws + WS_VH); ldo = 1024; cd = (pn - 8) * 256; }
            else if (pn < 16) { dst = (bf16_t*)(ws + WS_HGO); ldo = 1024; cd = (pn - 12) * 256; }
            else if (pn < 20) { dst = (bf16_t*)(ws + WS_AQ); ldo = 1024; cd = (pn - 16) * 256; }
            else if (pn < 24) { dst = (bf16_t*)(ws + WS_AK); ldo = 1024; cd = (pn - 20) * 256; }
            else if (pn < 28) { dst = (bf16_t*)(ws + WS_IQ); ldo = 1024; cd = (pn - 24) * 256; }
            else { dst = (bf16_t*)(ws + WS_GAB); ldo = 4096; cd = (pn - 28) * 256; }
        }
        const float sc = (mode == E_AQ) ? 0.08838834764831845f * 1.4426950408889634f : 1.0f;
#pragma unroll
        for (int bj = 0; bj < 2; ++bj) {
            f32x4 b0 = (f32x4){0.f, 0.f, 0.f, 0.f}, b1 = b0;
            if (bias) { b0 = *(const f32x4*)(bias + ct + bj * 128); b1 = *(const f32x4*)(bias + ct + bj * 128 + 4); }
#pragma unroll
            for (int ai = 0; ai < 2; ++ai)
#pragma unroll
                for (int m = 0; m < 4; ++m) {
                    f32x4 v0 = acc[ai][bj][m][0] + b0, v1 = acc[ai][bj][m][1] + b1;
                    if (mode == E_SILU) {
#pragma unroll
                        for (int e = 0; e < 4; ++e) { v0[e] = silu_f(v0[e]); v1[e] = silu_f(v1[e]); }
                    } else if (mode == E_SIG) {
#pragma unroll
                        for (int e = 0; e < 4; ++e) { v0[e] = sigmoid_f(v0[e]); v1[e] = sigmoid_f(v1[e]); }
                    } else if (mode == E_AQ) { v0 = v0 * sc; v1 = v1 * sc; }
                    const int row = rb + ai * 128 + m * 16;
                    *(u32x4*)(dst + (size_t)row * ldo + cd + ct + bj * 128) = pack8(v0, v1);
                }
        }
        return false;
    }
    if (mode == E_HF) {
        const int pn = u.pn; const float* bias = (const float*)(ws + WS_MISC) + pn * 256;
        const float* lbp = (const float*)(ws + WS_MISC + 65536) + (pn - 4) * 256;
        bf16_t* kh = (bf16_t*)(ws + WS_KH); float* lf = (float*)(ws + WS_LF); const int cd = (pn - 4) * 256;
#pragma unroll
        for (int bj = 0; bj < 2; ++bj) {
            const f32x4 b0 = *(const f32x4*)(bias + ct + bj * 128), b1 = *(const f32x4*)(bias + ct + bj * 128 + 4);
            const f32x4 l0 = *(const f32x4*)(lbp + ct + bj * 128), l1 = *(const f32x4*)(lbp + ct + bj * 128 + 4);
#pragma unroll
            for (int ai = 0; ai < 2; ++ai)
#pragma unroll
                for (int m = 0; m < 4; ++m) {
                    const f32x4 z0 = acc[ai][bj][m][0] + b0, z1 = acc[ai][bj][m][1] + b1; f32x4 k0, k1, g0, g1;
#pragma unroll
                    for (int e = 0; e < 4; ++e) {
                        const float s0 = sigmoid_f(z0[e]), s1 = sigmoid_f(z1[e]);
                        k0[e] = (1.f - l0[e]) * (1.f - s0); k1[e] = (1.f - l1[e]) * (1.f - s1);
                        g0[e] = __logf(l0[e] + (1.f - l0[e]) * s0); g1[e] = __logf(l1[e] + (1.f - l1[e]) * s1);
                    }
                    const int row = rb + ai * 128 + m * 16; const size_t o = (size_t)row * 1024 + cd + ct + bj * 128;
                    *(u32x4*)(kh + o) = pack8(k0, k1); *(f32x4*)(lf + o) = g0; *(f32x4*)(lf + o + 4) = g1;
                }
        }
        return false;
    }
    if (mode == E_IKW) {
        const float* bias = (const float*)(ws + WS_MISC) + 44 * 256;
        bf16_t* ik = (bf16_t*)(ws + WS_IK); float* iw = (float*)(ws + WS_IW);
        if (ct < 80) {
            const f32x4 b0 = *(const f32x4*)(bias + ct), b1 = *(const f32x4*)(bias + ct + 4);
#pragma unroll
            for (int ai = 0; ai < 2; ++ai)
#pragma unroll
                for (int m = 0; m < 4; ++m) {
                    const f32x4 v0 = acc[ai][0][m][0] + b0, v1 = acc[ai][0][m][1] + b1; const int row = rb + ai * 128 + m * 16;
                    if (ct < 64) *(u32x4*)(ik + (size_t)row * 64 + ct) = pack8(v0, v1);
                    else { *(f32x4*)(iw + (size_t)row * 16 + (ct - 64)) = v0 * 0.03125f; *(f32x4*)(iw + (size_t)row * 16 + (ct - 64) + 4) = v1 * 0.03125f; }
                }
        }
        return false;
    }
    if (mode == E_VT) {
        const float* bav = (const float*)(ws + WS_MISC + 524288); bf16_t* vt = (bf16_t*)(ws + WS_VT);
#pragma unroll
        for (int ai = 0; ai < 2; ++ai)
#pragma unroll
            for (int m = 0; m < 4; ++m) {
                const int row = rb + ai * 128 + m * 16; const float b = bav[row];
#pragma unroll
                for (int bj = 0; bj < 2; ++bj) { const f32x4 v0 = acc[ai][bj][m][0] + b, v1 = acc[ai][bj][m][1] + b;
                    *(u32x4*)(vt + (size_t)row * NTOK + u.pn * 256 + ct + bj * 128) = pack8(v0, v1); }
            }
        return false;
    }
    if (mode == E_MIX1 || mode == E_MIX2) {
        const bf16_t* gab = (const bf16_t*)(ws + WS_GAB) + (mode == E_MIX2 ? 2048 : 0); bf16_t* mixed = (bf16_t*)(ws + WS_MIXED);
#pragma unroll
        for (int ai = 0; ai < 2; ++ai)
#pragma unroll
            for (int m = 0; m < 4; ++m) {
                const int row = rb + ai * 128 + m * 16;
#pragma unroll
                for (int bj = 0; bj < 2; ++bj) {
                    const int col = u.pn * 256 + ct + bj * 128; f32x4 g0, g1;
                    unpack8(*(const u32x4*)(gab + (size_t)row * 4096 + col), g0, g1);
                    f32x4 v0 = acc[ai][bj][m][0] * g0, v1 = acc[ai][bj][m][1] * g1;
                    if (mode == E_MIX2) { f32x4 t0, t1; unpack8(*(const u32x4*)(mixed + (size_t)row * D + col), t0, t1); v0 = v0 + t0; v1 = v1 + t1; }
                    *(u32x4*)(mixed + (size_t)row * D + col) = pack8(v0, v1);
                }
                asm volatile("" ::: "memory");
            }
        return false;
    }
    if (mode == E_X1) {
#pragma unroll
        for (int ai = 0; ai < 2; ++ai)
#pragma unroll
            for (int m = 0; m < 4; ++m) {
                const int row = rb + ai * 128 + m * 16;
#pragma unroll
                for (int bj = 0; bj < 2; ++bj) { const size_t o = (size_t)row * D + u.pn * 256 + ct + bj * 128;
                    *(f32x4*)(P.out + o) = *(const f32x4*)(P.x + o) + acc[ai][bj][m][0]; *(f32x4*)(P.out + o + 4) = *(const f32x4*)(P.x + o + 4) + acc[ai][bj][m][1]; }
            }
        return false;
    }
    if (mode == E_HID) {
        const float* rsl = (const float*)(ws + WS_RSL) + u.ex * 8192 + (u.gidx - ((const int*)(ws + WS_LIST) + u.ex * 8192));
        bf16_t* hid = (bf16_t*)(ws + WS_HID);
#pragma unroll
        for (int ai = 0; ai < 2; ++ai)
#pragma unroll
            for (int m = 0; m < 4; ++m) {
                const int rl = wr * 64 + fr + ai * 128 + m * 16; const float rs = rl < u.gcnt ? rsl[rl] : 0.f; f32x4 h0, h1;
#pragma unroll
                for (int e = 0; e < 4; ++e) { h0[e] = silu_f(rs * acc[ai][0][m][0][e]) * (rs * acc[ai][1][m][0][e]); h1[e] = silu_f(rs * acc[ai][0][m][1][e]) * (rs * acc[ai][1][m][1][e]); }
                *(u32x4*)(hid + (size_t)(u.pm * 256 + rl) * 512 + u.pn * 128 + ct) = pack8(h0, h1);
            }
        return false;
    }
    if (mode == E_PLEG) {
        const float* rs3 = (const float*)(ws + WS_MISC + 655360); const bf16_t* pp = (const bf16_t*)(ws + WS_PP);
#pragma unroll
        for (int ai = 0; ai < 2; ++ai)
#pragma unroll
            for (int m = 0; m < 4; ++m) {
                const int row = rb + ai * 128 + m * 16; const float rs = rs3[row];
#pragma unroll
                for (int bj = 0; bj < 2; ++bj) { const size_t o = (size_t)row * D + u.pn * 256 + ct + bj * 128; f32x4 p0, p1; unpack8(*(const u32x4*)(pp + o), p0, p1);
                    f32x4 x0 = *(const f32x4*)(P.out + o), x1 = *(const f32x4*)(P.out + o + 4);
#pragma unroll
                    for (int e = 0; e < 4; ++e) { x0[e] += sigmoid_f(rs * acc[ai][bj][m][0][e]) * p0[e]; x1[e] += sigmoid_f(rs * acc[ai][bj][m][1][e]) * p1[e]; }
                    *(f32x4*)(P.out + o) = x0; *(f32x4*)(P.out + o + 4) = x1; }
            }
        return false;
    }
    return false;
}

__device__ __forceinline__ void lane_offsets(int lda, int ldb, int tid, unsigned (&vA)[2], unsigned (&vB)[2]) {
#pragma unroll
    for (int i = 0; i < 2; ++i) {
        int R, C; stage_rc(tid * 16 + i * 8192, R, C);
        const int Rb = (R & ~31) + perm32(R & 31);
        vB[i] = (unsigned)(Rb * ldb + C * 2); vA[i] = (unsigned)(R * lda + C * 2);
    }
}
__device__ __forceinline__ void gather_offsets(const GU& u, int tid, unsigned (&g0)[2], unsigned (&g1)[2]) {
#pragma unroll
    for (int i = 0; i < 2; ++i) {
        int R, C; stage_rc(tid * 16 + i * 8192, R, C);
        const int r0 = (R < u.gcnt) ? u.gidx[R] : 0, r1 = (R + 128 < u.gcnt) ? u.gidx[R + 128] : 0;
        g0[i] = (unsigned)(r0 * u.lda + C * 2); g1[i] = (unsigned)(r1 * u.lda + C * 2);
    }
}

template <int PH, bool GATHER>
__device__ __forceinline__ void gemm_phase(const Params& P, LAS unsigned char* lds, const LAS int* lctl, int WID) {
    const int tid = opaque_tid(), wid = __builtin_amdgcn_readfirstlane(tid >> 6), lane = tid & 63, wr = wid >> 2, wc = wid & 3, fr = lane & 15, fq = lane >> 4;
    const int G = gridDim.x, c = blockIdx.x;
    const size_t kstep = (size_t)(BK * 2);
    const unsigned ldsw = (unsigned)wid * 1024u;
    const int aoff = lds_byte(wr * 64 + fr, fq * 8), boff = lds_byte(wc * 32 + fr, fq * 8);
#define PG8_SA(b, h) (((b) * 2 + (h)) * HTB)
#define PG8_SB(b, h) ((4 + (b) * 2 + (h)) * HTB)
#define PG8_STAGE(bufoff, gbase, voff) do { _Pragma("unroll") for (int _i = 0; _i < 2; ++_i) \
        __builtin_amdgcn_global_load_lds((const unsigned*)((const char*)(gbase) + (voff)[_i]), (LAS unsigned*)(lds + (bufoff) + ldsw + _i * 8192), 16, 0, 0); } while (0)
#define PG8_LDA(dst, b, h) do { _Pragma("unroll") for (int m = 0; m < 4; ++m) _Pragma("unroll") for (int k = 0; k < 2; ++k) dst[m][k] = *(const LAS bf16x8*)(lds + PG8_SA(b, h) + aoff + m * 2048 + k * 1024); } while (0)
#define PG8_LDB(dst, b, h) do { _Pragma("unroll") for (int n = 0; n < 2; ++n) _Pragma("unroll") for (int k = 0; k < 2; ++k) dst[n][k] = *(const LAS bf16x8*)(lds + PG8_SB(b, h) + boff + n * 2048 + k * 1024); } while (0)
#define PG8_MMA(ai, bj, At, Bt) do { __builtin_amdgcn_s_setprio(1); _Pragma("unroll") for (int m = 0; m < 4; ++m) _Pragma("unroll") for (int n = 0; n < 2; ++n) _Pragma("unroll") for (int k = 0; k < 2; ++k) \
        acc[ai][bj][m][n] = __builtin_amdgcn_mfma_f32_16x16x32_bf16(Bt[n][k], At[m][k], acc[ai][bj][m][n], 0, 0, 0); __builtin_amdgcn_s_setprio(0); } while (0)
#define PG8_WAIT_V(n) asm volatile("s_waitcnt vmcnt(" #n ")" ::: "memory")
#define PG8_WAIT_L(n) asm volatile("s_waitcnt lgkmcnt(" #n ")" ::: "memory")
#define PG8_BAR __builtin_amdgcn_s_barrier()
#define PG8_SCHED __builtin_amdgcn_sched_barrier(0)
    GU cur, nxt; int ui = 0;
    if (!unit_next(P, PH, 0, c, G, lctl, cur)) return;
    f32x4 acc[2][2][4][2];
#pragma unroll
    for (int a = 0; a < 2; ++a)
#pragma unroll
        for (int b = 0; b < 2; ++b)
#pragma unroll
            for (int m = 0; m < 4; ++m)
#pragma unroll
                for (int n = 0; n < 2; ++n) acc[a][b][m][n] = (f32x4){0.f, 0.f, 0.f, 0.f};
    bf16x8 At[4][2], B0[2][2], B1[2][2];
    const int nt = cur.nt;
    const size_t hB = (size_t)128 * cur.ldb, hA = GATHER ? (size_t)0 : (size_t)128 * cur.lda;
    unsigned vA[2], vB[2], vA1[2], nA0[2], nA1[2];
    lane_offsets(cur.lda, cur.ldb, tid, vA, vB);
    if (GATHER) gather_offsets(cur, tid, vA, vA1);
    const char* cA = cur.A; const char* cB = cur.B;
#define VA1 (GATHER ? vA1 : vA)
    PG8_STAGE(PG8_SB(0, 0), cB, vB); PG8_STAGE(PG8_SB(0, 1), cB + hB, vB); PG8_STAGE(PG8_SA(0, 0), cA, vA); PG8_STAGE(PG8_SA(0, 1), cA + hA, VA1);
    if (wr == 1) PG8_BAR;
    PG8_WAIT_V(2); PG8_BAR;
    PG8_STAGE(PG8_SB(1, 0), cB + kstep, vB); PG8_STAGE(PG8_SA(1, 0), cA + kstep, vA); PG8_STAGE(PG8_SB(1, 1), cB + hB + kstep, vB);
    PG8_WAIT_V(6); PG8_BAR;
    for (;;) {
        const bool has_next = unit_next(P, PH, ui + 1, c, G, lctl, nxt);
        const char* nA = has_next ? nxt.A : cA; const char* nB = has_next ? nxt.B : cB;
        if (GATHER) {
            if (has_next) gather_offsets(nxt, tid, nA0, nA1);
            else {
#pragma unroll
                for (int i = 0; i < 2; ++i) { nA0[i] = vA[i]; nA1[i] = vA1[i]; }
            }
        }
        for (int t = 0; t < nt; t += 2) {
            const bool last = (t == nt - 2);
            const char* a1 = cA + (size_t)(t + 1) * kstep;
            const char* a2 = last ? nA : cA + (size_t)(t + 2) * kstep; const char* b2 = last ? nB : cB + (size_t)(t + 2) * kstep;
            const char* a3 = a2 + kstep; const char* b3 = b2 + kstep;
            unsigned sA0[2], sA1[2];
#pragma unroll
            for (int i = 0; i < 2; ++i) { sA0[i] = (GATHER && last) ? nA0[i] : vA[i]; sA1[i] = GATHER ? (last ? nA1[i] : vA1[i]) : vA[i]; }
            PG8_LDB(B0, 0, 0); PG8_LDB(B1, 0, 1); PG8_SCHED; PG8_LDA(At, 0, 0); PG8_STAGE(PG8_SA(1, 1), a1 + hA, VA1);
            PG8_WAIT_V(8); PG8_WAIT_L(0); PG8_BAR; PG8_MMA(0, 0, At, B0); PG8_MMA(0, 1, At, B1); PG8_BAR; PG8_SCHED;
            PG8_LDA(At, 0, 1); PG8_STAGE(PG8_SB(0, 0), b2, vB); PG8_STAGE(PG8_SB(0, 1), b2 + hB, vB); PG8_STAGE(PG8_SA(0, 0), a2, sA0);
            PG8_WAIT_V(8); PG8_WAIT_L(0); PG8_BAR; PG8_MMA(1, 0, At, B0); PG8_MMA(1, 1, At, B1); PG8_BAR; PG8_SCHED;
            PG8_LDB(B0, 1, 0); PG8_LDB(B1, 1, 1); PG8_SCHED; PG8_LDA(At, 1, 0); PG8_STAGE(PG8_SA(0, 1), a2 + hA, sA1);
            PG8_WAIT_V(8); PG8_WAIT_L(0); PG8_BAR; PG8_MMA(0, 0, At, B0); PG8_MMA(0, 1, At, B1); PG8_BAR; PG8_SCHED;
            PG8_LDA(At, 1, 1); PG8_STAGE(PG8_SB(1, 0), b3, vB); PG8_STAGE(PG8_SB(1, 1), b3 + hB, vB); PG8_STAGE(PG8_SA(1, 0), a3, sA0);
            PG8_WAIT_V(8); PG8_WAIT_L(0); PG8_BAR; PG8_MMA(1, 0, At, B0); PG8_MMA(1, 1, At, B1); PG8_BAR; PG8_SCHED;
        }
        if (wr == 0) PG8_BAR;
        const bool keep = gemm_epilogue(P, cur, acc, WID);
        if (!has_next) break;
        if (!keep) {
#pragma unroll
            for (int a = 0; a < 2; ++a)
#pragma unroll
                for (int b = 0; b < 2; ++b)
#pragma unroll
                    for (int m = 0; m < 4; ++m)
#pragma unroll
                        for (int n = 0; n < 2; ++n) acc[a][b][m][n] = (f32x4){0.f, 0.f, 0.f, 0.f};
        }
        cur = nxt; cA = nA; cB = nB; ++ui;
        if (GATHER) {
#pragma unroll
            for (int i = 0; i < 2; ++i) { vA[i] = nA0[i]; vA1[i] = nA1[i]; }
        }
        if (wr == 1) PG8_BAR;
    }
    PG8_WAIT_V(0);
    PG8_BAR;
#undef VA1
#undef PG8_SA
#undef PG8_SB
#undef PG8_STAGE
#undef PG8_LDA
#undef PG8_LDB
#undef PG8_MMA
#undef PG8_WAIT_V
#undef PG8_WAIT_L
#undef PG8_BAR
#undef PG8_SCHED
}

__device__ __forceinline__ void tr_item(const float* W, size_t srcpitch, int scol, int k0, bf16_t* dst, int dK, int drow0, LAS unsigned* scr, int lane) {
    const float* src = W + (size_t)k0 * srcpitch + (scol < 0 ? 0 : scol);
#pragma unroll 8
    for (int i = 0; i < 32; ++i) {
        float v0 = 0.f, v1 = 0.f;
        if (scol >= 0) { v0 = src[(size_t)(2 * i) * srcpitch]; v1 = src[(size_t)(2 * i + 1) * srcpitch]; }
        scr[lane * 33 + i] = cvt_pk_bf16(v0, v1);
    }
    LDS_WAIT(); asm volatile("" ::: "memory");
    const int cch = lane & 7;
#pragma unroll
    for (int j = 0; j < 8; ++j) {
        const int n = (lane >> 3) + 8 * j; const LAS unsigned* s = scr + n * 33 + 4 * cch;
        u32x4 o; o.x = s[0]; o.y = s[1]; o.z = s[2]; o.w = s[3];
        *(u32x4*)(dst + (size_t)(drow0 + n) * dK + k0 + 8 * cch) = o;
    }
    LDS_WAIT(); asm volatile("" ::: "memory");
}
__device__ __forceinline__ int win_srccol(int r) {
    if (r < 6144) return r;
    if (r < 7168) return 7168 + (r - 6144);
    if (r < 11264) return 8272 + (r - 7168);
    if (r < 11344) return 8192 + (r - 11264);
    return -1;
}
__device__ __forceinline__ void prologue_phase(const Params& P, LAS unsigned char* lds, int WID) {
    unsigned char* ws = P.ws;
    const int tid = opaque_tid(), lane = tid & 63, wave = tid >> 6;
    const int gw = blockIdx.x * NWAVES + wave, NGW = gridDim.x * NWAVES;
    LAS unsigned* scr = (LAS unsigned*)(lds + wave * 8448);
    constexpr int I_WIN = 32 * 180, I_WAV = 32 * 16, I_HG = 16 * 32, I_AT = 16 * 32, I_OUT = 32 * 32, I_PG = 32 * 32, I_PPJ = 4 * 32;
    constexpr int NIT = I_WIN + I_WAV + I_HG + I_AT + I_OUT + I_PG + I_PPJ;
    for (int it = gw; it < NIT; it += NGW) {
        int r = it;
        if (r < I_WIN) { const int nb = r % 180, kb = r / 180; tr_item(P.w_in, D_IN, win_srccol(nb * 64 + lane), kb * 64, (bf16_t*)(ws + WS_WIN), 2048, nb * 64, scr, lane); continue; } r -= I_WIN;
        if (r < I_WAV) { const int nb = r % 16, kb = r / 16; tr_item(P.w_in, D_IN, 6144 + nb * 64 + lane, kb * 64, (bf16_t*)(ws + WS_WAV), 2048, nb * 64, scr, lane); continue; } r -= I_WAV;
        if (r < I_HG) { const int nb = r % 32, kb = r / 32; tr_item(P.w_hg_up, 2048, nb * 64 + lane, kb * 64, (bf16_t*)(ws + WS_WHG), 1024, nb * 64, scr, lane); continue; } r -= I_HG;
        if (r < I_AT) { const int nb = r % 32, kb = r / 32; tr_item(P.w_attn_up, 2048, nb * 64 + lane, kb * 64, (bf16_t*)(ws + WS_WAT), 1024, nb * 64, scr, lane); continue; } r -= I_AT;
        if (r < I_OUT) { const int nb = r % 32, kb = r / 32; tr_item(P.w_out, 2048, nb * 64 + lane, kb * 64, (bf16_t*)(ws + WS_WOUT), 2048, nb * 64, scr, lane); continue; } r -= I_OUT;
        if (r < I_PG) { const int nb = r % 32, kb = r / 32; tr_item(P.w_pg, 2048, nb * 64 + lane, kb * 64, (bf16_t*)(ws + WS_WPG), 2048, nb * 64, scr, lane); continue; } r -= I_PG;
        { const int nb = r % 32, kb = r / 32; tr_item(P.w_pp, 2048, nb * 64 + lane, kb * 64, (bf16_t*)(ws + WS_WPP), 256, nb * 64, scr, lane); }
    }
    for (int m = gw; m < NTOK; m += NGW) {
        const f32x4* xr = (const f32x4*)(P.x + (size_t)m * D) + lane; f32x4 v[8]; float s = 0.f;
#pragma unroll
        for (int j = 0; j < 8; ++j) { v[j] = xr[64 * j]; s += (v[j][0] * v[j][0] + v[j][1] * v[j][1]) + (v[j][2] * v[j][2] + v[j][3] * v[j][3]); }
        const float rstd = rsqrtf(wave_sum(s) * (1.f / D) + RMS_EPS);
        u32x2* o = (u32x2*)((bf16_t*)(ws + WS_XN) + (size_t)m * D) + lane; const f32x4* g = (const f32x4*)P.attn_norm + lane;
#pragma unroll
        for (int j = 0; j < 8; ++j) { const f32x4 gg = g[64 * j]; u32x2 w; w.x = cvt_pk_bf16(v[j][0] * rstd * gg[0], v[j][1] * rstd * gg[1]); w.y = cvt_pk_bf16(v[j][2] * rstd * gg[2], v[j][3] * rstd * gg[3]); o[64 * j] = w; }
    }
    for (int m = gw; m < NTOK; m += NGW) { const f32x4 v = ((const f32x4*)(P.p + (size_t)m * PLE))[lane]; u32x2 w; w.x = cvt_pk_bf16(v[0], v[1]); w.y = cvt_pk_bf16(v[2], v[3]); ((u32x2*)((bf16_t*)(ws + WS_PBF) + (size_t)m * PLE))[lane] = w; }
    const int gt = blockIdx.x * NTHR + tid, NGT = gridDim.x * NTHR;
    float* binp = (float*)(ws + WS_MISC); float* lb = (float*)(ws + WS_MISC + 65536); float* wrt = (float*)(ws + WS_MISC + 131072); float* bav = (float*)(ws + WS_MISC + 524288);
    for (int i = gt; i < N1; i += NGT) { const int sc = win_srccol(i); binp[i] = sc < 0 ? 0.f : P.b_in[sc]; }
    for (int i = gt; i < 1024; i += NGT) { lb[i] = 1.f / (1.f + __expf(P.lb_logits[1024 + i] - P.lb_logits[i])); bav[i] = P.b_in[6144 + i]; }
    for (int i = gt; i < 36 * 2048; i += NGT) { const int o = i / 2048, k = i % 2048; wrt[i] = P.ffn_norm[k] * (o < 4 ? P.w_rg[k * 4 + o] : P.w_re[k * 32 + (o - 4)]); }
}

__device__ __forceinline__ void expert_convert_phase(const Params& P, LAS unsigned char* lds, int WID) {
    unsigned char* ws = P.ws;
    const int tid = opaque_tid(), lane = tid & 63, wave = tid >> 6;
    const int gw = blockIdx.x * NWAVES + wave, NGW = gridDim.x * NWAVES;
    LAS unsigned* scr = (LAS unsigned*)(lds + wave * 8448);
    constexpr int PER_E_GU = 32 * 8, PER_E_D = 8 * 32;
    constexpr int NIT = NE * (2 * PER_E_GU + PER_E_D);
    for (int it = gw; it < NIT; it += NGW) {
        const int e = it / (2 * PER_E_GU + PER_E_D); int r = it % (2 * PER_E_GU + PER_E_D);
        if (r < 2 * PER_E_GU) {
            const int up = r >= PER_E_GU; if (up) r -= PER_E_GU;
            const int nb = r % 8, kb = r / 8;
            const int drow = (nb >> 1) * 256 + up * 128 + (nb & 1) * 64;
            tr_item((up ? P.w_eu : P.w_eg) + (size_t)e * 2048 * 512, 512, nb * 64 + lane, kb * 64, (bf16_t*)(ws + WS_WGU) + (size_t)e * 1024 * 2048, 2048, drow, scr, lane);
        } else {
            r -= 2 * PER_E_GU; const int nb = r % 32, kb = r / 32;
            tr_item(P.w_ed + (size_t)e * 512 * 2048, 2048, nb * 64 + lane, kb * 64, (bf16_t*)(ws + WS_WD) + (size_t)e * 2048 * 512, 512, nb * 64, scr, lane);
        }
    }
}

__device__ __forceinline__ void final_norm_phase(const Params& P, int WID) {
    const int tid = opaque_tid(), lane = tid & 63, wave = tid >> 6;
    const int gw = blockIdx.x * NWAVES + wave, NGW = gridDim.x * NWAVES;
    for (int m = gw; m < NTOK; m += NGW) {
        f32x4* xr = (f32x4*)(P.out + (size_t)m * D) + lane; f32x4 v[8]; float s = 0.f;
#pragma unroll
        for (int j = 0; j < 8; ++j) { v[j] = xr[64 * j]; s += (v[j][0] * v[j][0] + v[j][1] * v[j][1]) + (v[j][2] * v[j][2] + v[j][3] * v[j][3]); }
        const float rstd = rsqrtf(wave_sum(s) * (1.f / D) + RMS_EPS); const f32x4* g = (const f32x4*)P.final_norm + lane;
#pragma unroll
        for (int j = 0; j < 8; ++j) xr[64 * j] = v[j] * rstd * g[64 * j];
    }
}
__device__ __forceinline__ void copy_x_phase(const Params& P, int WID) {
    const int gt = blockIdx.x * NTHR + opaque_tid(), NGT = gridDim.x * NTHR;
    for (int i = gt; i < NTOK * D / 4; i += NGT) ((f32x4*)P.out)[i] = ((const f32x4*)P.x)[i];
}

__device__ __forceinline__ void router_phase(const Params& P, LAS unsigned char* lds, int WID) {
    unsigned char* ws = P.ws;
    const int tid = opaque_tid(), lane = tid & 63, wave = tid >> 6;
    const float* wrt = (const float*)(ws + WS_MISC + 131072);
    LAS float* wl = (LAS float*)lds;
    unsigned* cnt = (unsigned*)(ws + WS_CTL) + CW_CNT;
    for (int item = blockIdx.x; item < NTOK / 16; item += gridDim.x) {
        const int tok0 = item * 16 + wave * 2;
        float ss[2];
#pragma unroll
        for (int q = 0; q < 2; ++q) {
            const f32x4* xr = (const f32x4*)(P.out + (size_t)(tok0 + q) * D) + lane; float sq = 0.f;
            u32x2* o = (u32x2*)((bf16_t*)(ws + WS_XN) + (size_t)(tok0 + q) * D) + lane; const f32x4* g = (const f32x4*)P.ffn_norm + lane;
#pragma unroll
            for (int j = 0; j < 8; ++j) { const f32x4 v = xr[64 * j], gg = g[64 * j]; sq += (v[0] * v[0] + v[1] * v[1]) + (v[2] * v[2] + v[3] * v[3]);
                u32x2 w; w.x = cvt_pk_bf16(v[0] * gg[0], v[1] * gg[1]); w.y = cvt_pk_bf16(v[2] * gg[2], v[3] * gg[3]); o[64 * j] = w; }
            ss[q] = sq;
        }
        float a[2][36];
#pragma unroll
        for (int q = 0; q < 2; ++q)
#pragma unroll
            for (int o = 0; o < 36; ++o) a[q][o] = 0.f;
        __syncthreads();
        for (int i = tid; i < 36 * 64; i += NTHR) { const int o = i >> 6, c4 = i & 63; *(LAS f32x4*)(wl + o * 256 + c4 * 4) = *(const f32x4*)(wrt + (size_t)o * 2048 + c4 * 4); }
        __syncthreads();
#pragma unroll 1
        for (int j = 0; j < 8; ++j) {
            if (j < 7) { LAS float* wn = wl + ((j + 1) & 1) * 36 * 256;
                for (int i = tid; i < 36 * 64; i += NTHR) { const int o = i >> 6, c4 = i & 63; *(LAS f32x4*)(wn + o * 256 + c4 * 4) = *(const f32x4*)(wrt + (size_t)o * 2048 + (j + 1) * 256 + c4 * 4); } }
            const LAS float* wc = wl + (j & 1) * 36 * 256;
            const f32x4 v0 = ((const f32x4*)(P.out + (size_t)tok0 * D))[64 * j + lane], v1 = ((const f32x4*)(P.out + (size_t)(tok0 + 1) * D))[64 * j + lane];
#pragma unroll
            for (int o = 0; o < 36; ++o) { const f32x4 w = *(const LAS f32x4*)(wc + o * 256 + lane * 4);
                a[0][o] += (v0[0] * w[0] + v0[1] * w[1]) + (v0[2] * w[2] + v0[3] * w[3]); a[1][o] += (v1[0] * w[0] + v1[1] * w[1]) + (v1[2] * w[2] + v1[3] * w[3]); }
            __syncthreads();
        }
#pragma unroll
        for (int q = 0; q < 2; ++q) {
            const float rstd = rsqrtf(wave_sum(ss[q]) * (1.f / D) + RMS_EPS);
            float l[36];
#pragma unroll
            for (int o = 0; o < 36; ++o) l[o] = wave_sum(a[q][o]) * rstd + (o < 4 ? P.b_rg[o] : P.b_re[o - 4]);
            int gid = 0; float gm = l[0];
#pragma unroll
            for (int o = 1; o < 4; ++o) if (l[o] > gm) { gm = l[o]; gid = o; }
            float gz = 0.f;
#pragma unroll
            for (int o = 0; o < 4; ++o) gz += __expf(l[o] - gm);
            const float pg = 1.f / gz;
            float e[8];
#pragma unroll
            for (int k = 0; k < 8; ++k) e[k] = gid == 0 ? l[4 + k] : gid == 1 ? l[12 + k] : gid == 2 ? l[20 + k] : l[28 + k];
            int i1 = 0; float m1 = e[0];
#pragma unroll
            for (int k = 1; k < 8; ++k) if (e[k] > m1) { m1 = e[k]; i1 = k; }
            int i2 = -1; float m2 = -INFINITY;
#pragma unroll
            for (int k = 0; k < 8; ++k) if (k != i1 && e[k] > m2) { m2 = e[k]; i2 = k; }
            const float r = __expf(m2 - m1), w1 = pg / (1.f + r), w2 = pg * r / (1.f + r);
            if (lane == 0) {
                const int tok = tok0 + q, e1 = gid * 8 + i1, e2 = gid * 8 + i2;
                const int p1 = (int)atomicAdd(cnt + e1, 1u), p2 = (int)atomicAdd(cnt + e2, 1u);
                int* route = (int*)(ws + WS_ROUTE) + tok * 8;
                route[0] = e1; route[1] = p1; route[2] = e2; route[3] = p2; ((float*)route)[4] = w1; ((float*)route)[5] = w2;
                ((int*)(ws + WS_LIST))[e1 * 8192 + p1] = tok; ((int*)(ws + WS_LIST))[e2 * 8192 + p2] = tok;
                ((float*)(ws + WS_RSL))[e1 * 8192 + p1] = rstd; ((float*)(ws + WS_RSL))[e2 * 8192 + p2] = rstd;
            }
        }
    }
}
__device__ __forceinline__ void moe_tables(const Params& P, LAS int* lctl, int WID) {
    if (WID == 0) {
        const int lane = opaque_tid(); const unsigned* cnt = (const unsigned*)(P.ws + WS_CTL) + CW_CNT;
        const int c = lane < 32 ? (int)__hip_atomic_load(cnt + lane, __ATOMIC_RELAXED, __HIP_MEMORY_SCOPE_AGENT) : 0;
        const int nt = (c + 255) >> 8; int incl = nt;
#pragma unroll
        for (int o = 1; o < 32; o <<= 1) { const int t = __shfl_up(incl, o); if (lane >= o) incl += t; }
        const int excl = incl - nt;
        if (lane < 32) { lctl[(LC_CNT - LDSCTL_OFF) / 4 + lane] = c; lctl[(LC_TB - LDSCTL_OFF) / 4 + lane] = excl; for (int t = 0; t < nt; ++t) lctl[(LC_TEXP - LDSCTL_OFF) / 4 + excl + t] = lane; }
        if (lane == 31) lctl[(LC_TB - LDSCTL_OFF) / 4 + 32] = incl;
    }
    __syncthreads();
}
__device__ __forceinline__ void combine_phase(const Params& P, const LAS int* lctl, bool with_moe, int WID) {
    unsigned char* ws = P.ws;
    const int tid = opaque_tid(), lane = tid & 63, wave = tid >> 6;
    const int gw = blockIdx.x * NWAVES + wave, NGW = gridDim.x * NWAVES;
    float* rs3 = (float*)(ws + WS_MISC + 655360);
    for (int m = gw; m < NTOK; m += NGW) {
        f32x4* xr = (f32x4*)(P.out + (size_t)m * D) + lane; f32x4 v[8];
#pragma unroll
        for (int j = 0; j < 8; ++j) v[j] = xr[64 * j];
        if (with_moe) {
            const int* route = (const int*)(ws + WS_ROUTE) + m * 8;
            const int e1 = route[0], p1 = route[1], e2 = route[2], p2 = route[3]; const float w1 = ((const float*)route)[4], w2 = ((const float*)route)[5];
            const int r1 = lctl[(LC_TB - LDSCTL_OFF) / 4 + e1] * 256 + p1, r2 = lctl[(LC_TB - LDSCTL_OFF) / 4 + e2] * 256 + p2;
            const u32x2* y1 = (const u32x2*)((const bf16_t*)(ws + WS_Y) + (size_t)r1 * D) + lane; const u32x2* y2 = (const u32x2*)((const bf16_t*)(ws + WS_Y) + (size_t)r2 * D) + lane;
#pragma unroll
            for (int j = 0; j < 8; ++j) { const u32x2 a = y1[64 * j], b = y2[64 * j];
                v[j][0] += w1 * bflo(a.x) + w2 * bflo(b.x); v[j][1] += w1 * bfhi(a.x) + w2 * bfhi(b.x); v[j][2] += w1 * bflo(a.y) + w2 * bflo(b.y); v[j][3] += w1 * bfhi(a.y) + w2 * bfhi(b.y); }
#pragma unroll
            for (int j = 0; j < 8; ++j) xr[64 * j] = v[j];
        }
        float s = 0.f;
#pragma unroll
        for (int j = 0; j < 8; ++j) s += (v[j][0] * v[j][0] + v[j][1] * v[j][1]) + (v[j][2] * v[j][2] + v[j][3] * v[j][3]);
        const float rstd = rsqrtf(wave_sum(s) * (1.f / D) + RMS_EPS);
        if (lane == 0) rs3[m] = rstd;
        u32x2* o = (u32x2*)((bf16_t*)(ws + WS_XN) + (size_t)m * D) + lane; const f32x4* g = (const f32x4*)P.ple_norm + lane;
#pragma unroll
        for (int j = 0; j < 8; ++j) { const f32x4 gg = g[64 * j]; u32x2 w; w.x = cvt_pk_bf16(v[j][0] * gg[0], v[j][1] * gg[1]); w.y = cvt_pk_bf16(v[j][2] * gg[2], v[j][3] * gg[3]); o[64 * j] = w; }
    }
}

constexpr int HG_TS = 72;
__device__ __forceinline__ void hg_pass1(const Params& P, LAS unsigned char* lds, int ci, int WID) {
    unsigned char* ws = P.ws;
    const int tid = opaque_tid(), lane = tid & 63, wave = __builtin_amdgcn_readfirstlane(tid >> 6);
    const int bh = ci >> 5, n = ci & 31, b = bh >> 3, h = bh & 7, t0 = b * T + n * 64, c0 = h * 128;
    LAS bf16_t* KT = (LAS bf16_t*)lds;
    LAS bf16_t* VT = (LAS bf16_t*)(lds + 128 * HG_TS * 2);
    LAS float* tot = (LAS float*)(lds + 2 * 128 * HG_TS * 2);
    const int d = tid & 127, tq = tid >> 7;
    float* lf = (float*)(ws + WS_LF) + (size_t)(t0 + 16 * tq) * 1024 + c0 + d;
    float bb[16]; float run = 0.f;
#pragma unroll
    for (int j = 0; j < 16; ++j) { run += lf[(size_t)j * 1024]; bb[j] = run; }
    tot[tq * 128 + d] = run;
    __syncthreads();
    float off = 0.f, blast = 0.f;
#pragma unroll
    for (int q = 0; q < 4; ++q) { const float tv = tot[q * 128 + d]; blast += tv; if (q < tq) off += tv; }
#pragma unroll
    for (int j = 0; j < 16; ++j) { bb[j] += off; lf[(size_t)j * 1024] = bb[j]; }
    if (tq == 0) ((float*)(ws + WS_GDEC))[ci * 128 + d] = __expf(blast);
    const bf16_t* kh = (const bf16_t*)(ws + WS_KH) + (size_t)(t0 + 16 * tq) * 1024 + c0 + d;
    const bf16_t* vh = (const bf16_t*)(ws + WS_VH) + (size_t)(t0 + 16 * tq) * 1024 + c0 + d;
    unsigned kw[8], vw[8];
#pragma unroll
    for (int j = 0; j < 8; ++j) {
        const float k0 = bf2f(kh[(size_t)(2 * j) * 1024]) * __expf(blast - bb[2 * j]), k1 = bf2f(kh[(size_t)(2 * j + 1) * 1024]) * __expf(blast - bb[2 * j + 1]);
        kw[j] = cvt_pk_bf16(k0, k1);
        vw[j] = (unsigned)vh[(size_t)(2 * j) * 1024] | ((unsigned)vh[(size_t)(2 * j + 1) * 1024] << 16);
    }
    *(LAS u32x4*)(KT + d * HG_TS + 16 * tq) = (u32x4){kw[0], kw[1], kw[2], kw[3]}; *(LAS u32x4*)(KT + d * HG_TS + 16 * tq + 8) = (u32x4){kw[4], kw[5], kw[6], kw[7]};
    *(LAS u32x4*)(VT + d * HG_TS + 16 * tq) = (u32x4){vw[0], vw[1], vw[2], vw[3]}; *(LAS u32x4*)(VT + d * HG_TS + 16 * tq + 8) = (u32x4){vw[4], vw[5], vw[6], vw[7]};
    __syncthreads();
    const int r32 = lane & 31, hh = lane >> 5;
    float* U = (float*)(ws + WS_U) + (size_t)ci * 16384;
#pragma unroll
    for (int x = 0; x < 2; ++x) {
        const int tile = wave * 2 + x, dvt = tile >> 2, dkt = tile & 3;
        f32x16 acc = {};
#pragma unroll
        for (int s = 0; s < 4; ++s) {
            const bf16x8 af = *(const LAS bf16x8*)(VT + (dvt * 32 + r32) * HG_TS + 16 * s + 8 * hh);
            const bf16x8 bf = *(const LAS bf16x8*)(KT + (dkt * 32 + r32) * HG_TS + 16 * s + 8 * hh);
            acc = __builtin_amdgcn_mfma_f32_32x32x16_bf16(af, bf, acc, 0, 0, 0);
        }
#pragma unroll
        for (int i = 0; i < 16; ++i) { const int dv = dvt * 32 + (i & 3) + 8 * (i >> 2) + 4 * hh; U[dv * 128 + dkt * 32 + r32] = acc[i]; }
    }
    __syncthreads();
}
__device__ __forceinline__ void hg_scan(const Params& P, int WID) {
    unsigned char* ws = P.ws;
    const int gt = blockIdx.x * NTHR + opaque_tid(), NGT = gridDim.x * NTHR;
    for (int it = gt; it < 32 * 4096; it += NGT) {
        const int bh = it >> 12, e = (it & 4095) * 4, dk = e & 127;
        f32x4 S = {0.f, 0.f, 0.f, 0.f};
#pragma unroll 4
        for (int n = 0; n < 32; ++n) {
            const int ci = bh * 32 + n;
            u32x2 w; w.x = cvt_pk_bf16(S[0], S[1]); w.y = cvt_pk_bf16(S[2], S[3]);
            *(u32x2*)((bf16_t*)(ws + WS_ST) + (size_t)ci * 16384 + e) = w;
            const f32x4 g = *(const f32x4*)((const float*)(ws + WS_GDEC) + ci * 128 + dk);
            const f32x4 u = *(const f32x4*)((const float*)(ws + WS_U) + (size_t)ci * 16384 + e);
            S = g * S + u;
        }
    }
}
__device__ __forceinline__ void hg_pass3(const Params& P, LAS unsigned char* lds, int ci, int WID) {
    unsigned char* ws = P.ws;
    const int tid = opaque_tid(), lane = tid & 63, wave = __builtin_amdgcn_readfirstlane(tid >> 6);
    const int bh = ci >> 5, n = ci & 31, b = bh >> 3, h = bh & 7, t0 = b * T + n * 64, c0 = h * 128;
    LAS bf16_t* VT = (LAS bf16_t*)lds;
    LAS float* red = (LAS float*)(lds + 128 * HG_TS * 2);
    {
        const int d = tid & 127, tq = tid >> 7;
        const bf16_t* vh = (const bf16_t*)(ws + WS_VH) + (size_t)(t0 + 16 * tq) * 1024 + c0 + d; unsigned vw[8];
#pragma unroll
        for (int j = 0; j < 8; ++j) vw[j] = (unsigned)vh[(size_t)(2 * j) * 1024] | ((unsigned)vh[(size_t)(2 * j + 1) * 1024] << 16);
        *(LAS u32x4*)(VT + d * HG_TS + 16 * tq) = (u32x4){vw[0], vw[1], vw[2], vw[3]}; *(LAS u32x4*)(VT + d * HG_TS + 16 * tq + 8) = (u32x4){vw[4], vw[5], vw[6], vw[7]};
    }
    __syncthreads();
    const int dvt = wave & 3, tt = wave >> 2, r32 = lane & 31, hh = lane >> 5;
    const float* bc = (const float*)(ws + WS_LF);
    const bf16_t* qh = (const bf16_t*)(ws + WS_QH); const bf16_t* kh = (const bf16_t*)(ws + WS_KH);
    const size_t rowq = (size_t)(t0 + tt * 32 + r32) * 1024 + c0, rowm = (size_t)(t0 + 31) * 1024 + c0;
    bf16x8 Qs[8], Qp[8];
#pragma unroll
    for (int kk = 0; kk < 8; ++kk) {
        const int dd = 16 * kk + 8 * hh; f32x4 q0, q1; unpack8(*(const u32x4*)(qh + rowq + dd), q0, q1);
        const f32x4 b0 = *(const f32x4*)(bc + rowq + dd), b1 = *(const f32x4*)(bc + rowq + dd + 4), m0 = *(const f32x4*)(bc + rowm + dd), m1 = *(const f32x4*)(bc + rowm + dd + 4);
        f32x4 s0, s1, p0, p1;
#pragma unroll
        for (int e = 0; e < 4; ++e) { s0[e] = q0[e] * __expf(b0[e] - m0[e]); s1[e] = q1[e] * __expf(b1[e] - m1[e]); p0[e] = q0[e] * __expf(b0[e]); p1[e] = q1[e] * __expf(b1[e]); }
        Qs[kk] = __builtin_bit_cast(bf16x8, pack8(s0, s1)); Qp[kk] = __builtin_bit_cast(bf16x8, pack8(p0, p1));
    }
    f32x16 o = {};
#pragma unroll
    for (int st = 0; st < 2; ++st) {
        if (st <= tt) {
            const size_t rowk = (size_t)(t0 + st * 32 + r32) * 1024 + c0;
            f32x16 am = {};
#pragma unroll
            for (int kk = 0; kk < 8; ++kk) {
                const int dd = 16 * kk + 8 * hh; f32x4 k0, k1; unpack8(*(const u32x4*)(kh + rowk + dd), k0, k1);
                const f32x4 b0 = *(const f32x4*)(bc + rowk + dd), b1 = *(const f32x4*)(bc + rowk + dd + 4), m0 = *(const f32x4*)(bc + rowm + dd), m1 = *(const f32x4*)(bc + rowm + dd + 4);
#pragma unroll
                for (int e = 0; e < 4; ++e) { k0[e] *= __expf(m0[e] - b0[e]); k1[e] *= __expf(m1[e] - b1[e]); }
                am = __builtin_amdgcn_mfma_f32_32x32x16_bf16(__builtin_bit_cast(bf16x8, pack8(k0, k1)), Qs[kk], am, 0, 0, 0);
            }
            if (st == tt) {
#pragma unroll
                for (int i = 0; i < 16; ++i) { const int sl = (i & 3) + 8 * (i >> 2) + 4 * hh; if (sl > r32) am[i] = 0.f; }
            }
#pragma unroll
            for (int sp = 0; sp < 2; ++sp) {
                u32x4 pw; pw.x = cvt_pk_bf16(am[8 * sp + 0], am[8 * sp + 1]); pw.y = cvt_pk_bf16(am[8 * sp + 2], am[8 * sp + 3]); pw.z = cvt_pk_bf16(am[8 * sp + 4], am[8 * sp + 5]); pw.w = cvt_pk_bf16(am[8 * sp + 6], am[8 * sp + 7]);
                const LAS bf16_t* vp = VT + (dvt * 32 + r32) * HG_TS + st * 32 + 16 * sp + 4 * hh;
                const u32x2 va = *(const LAS u32x2*)vp, vb = *(const LAS u32x2*)(vp + 8);
                const u32x4 vf = (u32x4){va.x, va.y, vb.x, vb.y};
                o = __builtin_amdgcn_mfma_f32_32x32x16_bf16(__builtin_bit_cast(bf16x8, vf), __builtin_bit_cast(bf16x8, pw), o, 0, 0, 0);
            }
        }
    }
    const bf16_t* stp = (const bf16_t*)(ws + WS_ST) + (size_t)ci * 16384 + (size_t)(dvt * 32 + r32) * 128;
#pragma unroll
    for (int kk = 0; kk < 8; ++kk) {
        const bf16x8 sf = *(const bf16x8*)(stp + 16 * kk + 8 * hh);
        o = __builtin_amdgcn_mfma_f32_32x32x16_bf16(sf, Qp[kk], o, 0, 0, 0);
    }
    float ssq = 0.f;
#pragma unroll
    for (int i = 0; i < 16; ++i) ssq += o[i] * o[i];
    ssq += __shfl_xor(ssq, 32);
    if (hh == 0) red[(tt * 4 + dvt) * 32 + r32] = ssq;
    __syncthreads();
    const float tot = (red[(tt * 4 + 0) * 32 + r32] + red[(tt * 4 + 1) * 32 + r32]) + (red[(tt * 4 + 2) * 32 + r32] + red[(tt * 4 + 3) * 32 + r32]);
    const float rstd = rsqrtf(tot * (1.f / 128.f) + RMS_EPS);
    const bf16_t* hgo = (const bf16_t*)(ws + WS_HGO) + rowq; bf16_t* ohg = (bf16_t*)(ws + WS_OHG) + rowq;
#pragma unroll
    for (int g4 = 0; g4 < 4; ++g4) {
        const int dv0 = dvt * 32 + 8 * g4 + 4 * hh; const u32x2 hw = *(const u32x2*)(hgo + dv0); const f32x4 gn = *(const f32x4*)(P.hg_out_norm + dv0);
        const float v0 = o[4 * g4 + 0] * rstd * gn[0] * bflo(hw.x), v1 = o[4 * g4 + 1] * rstd * gn[1] * bfhi(hw.x), v2 = o[4 * g4 + 2] * rstd * gn[2] * bflo(hw.y), v3 = o[4 * g4 + 3] * rstd * gn[3] * bfhi(hw.y);
        u32x2 w; w.x = cvt_pk_bf16(v0, v1); w.y = cvt_pk_bf16(v2, v3); *(u32x2*)(ohg + dv0) = w;
    }
    __syncthreads();
}

__device__ __forceinline__ unsigned ord_key(float f) { const unsigned u = __float_as_uint(f); return (u & 0x80000000u) ? ~u : (u | 0x80000000u); }
__device__ __forceinline__ void indexer_item(const Params& P, LAS unsigned char* lds, int item, int WID) {
    unsigned char* ws = P.ws;
    const int tid = opaque_tid(), lane = tid & 63, wave = __builtin_amdgcn_readfirstlane(tid >> 6);
    const int b = item >> 7, qg = item & 127, tb = qg * 16 + wave * 2;
    LAS float* sc = (LAS float*)lds + (wave * 2) * 2048;
    const int r32 = lane & 31, hh = lane >> 5;
    const bf16_t* iq = (const bf16_t*)(ws + WS_IQ); const bf16_t* ik = (const bf16_t*)(ws + WS_IK);
    bf16x8 af[4];
    { const int qi = (r32 >> 2) & 1, hd = (r32 & 3) + 4 * (r32 >> 3); const bf16_t* ap = iq + (size_t)(b * T + tb + qi) * 1024 + hd * 64 + 8 * hh;
#pragma unroll
      for (int kk = 0; kk < 4; ++kk) af[kk] = *(const bf16x8*)(ap + 16 * kk); }
    float wq[16];
    { const f32x4* wp = (const f32x4*)((const float*)(ws + WS_IW) + (size_t)(b * T + tb + hh) * 16);
#pragma unroll
      for (int i = 0; i < 4; ++i) { const f32x4 w = wp[i]; wq[4 * i] = w[0]; wq[4 * i + 1] = w[1]; wq[4 * i + 2] = w[2]; wq[4 * i + 3] = w[3]; } }
    const int tq = tb + hh;
    const int nkt = (tb + 2 + 31) >> 5;
    for (int kt = 0; kt < nkt; ++kt) {
        const bf16_t* bp = ik + (size_t)(b * T + kt * 32 + r32) * 64 + 8 * hh;
        f32x16 acc = {};
#pragma unroll
        for (int kk = 0; kk < 4; ++kk) acc = __builtin_amdgcn_mfma_f32_32x32x16_bf16(af[kk], *(const bf16x8*)(bp + 16 * kk), acc, 0, 0, 0);
        float s = 0.f;
#pragma unroll
        for (int i = 0; i < 16; ++i) s += wq[i] * fmaxf(acc[i], 0.f);
        const int sp = kt * 32 + r32;
        sc[hh * 2048 + sp] = (sp <= tq) ? s : -INFINITY;
    }
    LDS_WAIT(); asm volatile("" ::: "memory");
    unsigned* mask = (unsigned*)(ws + WS_MASK);
    for (int qi = 0; qi < 2; ++qi) {
        const int t = tb + qi, nvalid = t + 1; unsigned wv;
        if (nvalid <= 256) {
            const int lo = lane * 32; wv = (lo + 31 <= t) ? 0xffffffffu : (lo <= t ? ((1u << (t - lo + 1)) - 1u) : 0u);
        } else {
            const int nj = (nvalid + 63) >> 6; unsigned key[32];
#pragma unroll
            for (int j = 0; j < 32; ++j) { const int s = j * 64 + lane; key[j] = (j < nj && s <= t) ? ord_key(sc[qi * 2048 + s]) : 0u; }
            unsigned thr = 0u;
            for (int bit = 31; bit >= 0; --bit) {
                const unsigned cand = thr | (1u << bit); int cnt = 0;
#pragma unroll
                for (int j = 0; j < 32; ++j) if (j < nj) cnt += __builtin_popcountll(__ballot(key[j] >= cand));
                if (cnt >= 256) thr = cand;
            }
            int ngt = 0;
#pragma unroll
            for (int j = 0; j < 32; ++j) if (j < nj) ngt += __builtin_popcountll(__ballot(key[j] > thr));
            int need = 256 - ngt; wv = 0u;
#pragma unroll
            for (int j = 0; j < 32; ++j) {
                unsigned long long w64 = 0ull;
                if (j < nj) {
                    const unsigned long long gt = __ballot(key[j] > thr); unsigned long long eq = __ballot(key[j] == thr);
                    int ce = __builtin_popcountll(eq);
                    if (ce > need) { unsigned long long tk = 0ull; for (int r = 0; r < need; ++r) { const unsigned long long low = eq & (0ull - eq); tk |= low; eq ^= low; } eq = tk; ce = need; }
                    need -= ce; w64 = gt | eq;
                }
                if ((lane >> 1) == j) wv = (lane & 1) ? (unsigned)(w64 >> 32) : (unsigned)w64;
            }
        }
        mask[(size_t)(b * T + t) * 64 + lane] = wv;
    }
}

__device__ __forceinline__ void attn_tile(const Params& P, int b, int h, int a, int WID) {
    unsigned char* ws = P.ws;
    const int lane = opaque_tid() & 63, c16 = lane & 15, g = lane >> 4;
    const bf16_t* aq = (const bf16_t*)(ws + WS_AQ); const bf16_t* ak = (const bf16_t*)(ws + WS_AK); const bf16_t* vt = (const bf16_t*)(ws + WS_VT);
    const unsigned* mask = (const unsigned*)(ws + WS_MASK);
    const int q0 = a * 16, t = q0 + c16; const size_t tokq = (size_t)b * T + t;
    bf16x8 qf[4];
#pragma unroll
    for (int kk = 0; kk < 4; ++kk) qf[kk] = *(const bf16x8*)(aq + tokq * 1024 + h * 128 + 32 * kk + 8 * g);
    const float slope2 = exp2f(-(float)(h + 1)) * 1.4426950408889634f;
    float m = -1e30f, lsum = 0.f;
    f32x4 o[8];
#pragma unroll
    for (int dt = 0; dt < 8; ++dt) o[dt] = (f32x4){0.f, 0.f, 0.f, 0.f};
    const int nsteps = (q0 + 16 + 31) >> 5;
    const unsigned* mrow = mask + tokq * 64;
    for (int ks = 0; ks < nsteps; ++ks) {
        const int k0 = ks * 32;
        const bf16_t* kp = ak + ((size_t)b * T + k0 + c16) * 1024 + h * 128 + 8 * g;
        f32x4 c0 = {0.f, 0.f, 0.f, 0.f}, c1 = {0.f, 0.f, 0.f, 0.f};
#pragma unroll
        for (int kk = 0; kk < 4; ++kk) {
            c0 = __builtin_amdgcn_mfma_f32_16x16x32_bf16(*(const bf16x8*)(kp + 32 * kk), qf[kk], c0, 0, 0, 0);
            c1 = __builtin_amdgcn_mfma_f32_16x16x32_bf16(*(const bf16x8*)(kp + 16 * 1024 + 32 * kk), qf[kk], c1, 0, 0, 0);
        }
        const unsigned mw = mrow[ks];
        float p[8]; float mx = -INFINITY;
#pragma unroll
        for (int i = 0; i < 4; ++i) {
            const int s0 = k0 + 4 * g + i, s1 = s0 + 16;
            p[i] = ((mw >> (4 * g + i)) & 1u) ? c0[i] - slope2 * (float)(t - s0) : -INFINITY;
            p[4 + i] = ((mw >> (16 + 4 * g + i)) & 1u) ? c1[i] - slope2 * (float)(t - s1) : -INFINITY;
            mx = fmaxf(mx, fmaxf(p[i], p[4 + i]));
        }
        mx = fmaxf(mx, __shfl_xor(mx, 16)); mx = fmaxf(mx, __shfl_xor(mx, 32));
        const float mn = fmaxf(m, mx), alpha = exp2f(m - mn); m = mn;
        float rs = 0.f;
#pragma unroll
        for (int i = 0; i < 8; ++i) { p[i] = exp2f(p[i] - mn); rs += p[i]; }
        lsum = lsum * alpha + rs;
#pragma unroll
        for (int dt = 0; dt < 8; ++dt) o[dt] = o[dt] * alpha;
        u32x4 pw; pw.x = cvt_pk_bf16(p[0], p[1]); pw.y = cvt_pk_bf16(p[2], p[3]); pw.z = cvt_pk_bf16(p[4], p[5]); pw.w = cvt_pk_bf16(p[6], p[7]);
        const bf16x8 pf = __builtin_bit_cast(bf16x8, pw);
        const bf16_t* vp = vt + (size_t)(h * 128 + c16) * NTOK + (size_t)b * T + k0 + 4 * g;
#pragma unroll
        for (int dt = 0; dt < 8; ++dt) {
            const u32x2 va = *(const u32x2*)(vp + (size_t)(16 * dt) * NTOK), vb = *(const u32x2*)(vp + (size_t)(16 * dt) * NTOK + 16);
            const u32x4 vf = (u32x4){va.x, va.y, vb.x, vb.y};
            o[dt] = __builtin_amdgcn_mfma_f32_16x16x32_bf16(__builtin_bit_cast(bf16x8, vf), pf, o[dt], 0, 0, 0);
        }
    }
    lsum += __shfl_xor(lsum, 16); lsum += __shfl_xor(lsum, 32);
    const float inv = 1.f / lsum;
    bf16_t* op = (bf16_t*)(ws + WS_OAT) + tokq * 1024 + h * 128 + 4 * g;
#pragma unroll
    for (int dt = 0; dt < 8; ++dt) { u32x2 w; w.x = cvt_pk_bf16(o[dt][0] * inv, o[dt][1] * inv); w.y = cvt_pk_bf16(o[dt][2] * inv, o[dt][3] * inv); *(u32x2*)(op + 16 * dt) = w; }
}

#ifndef DO_MIXER
#define DO_MIXER 1
#endif
#ifndef DO_ATTN
#define DO_ATTN 1
#endif
#ifndef DO_HG
#define DO_HG 1
#endif
#ifndef DO_MOE
#define DO_MOE 1
#endif
#ifndef DO_PLE
#define DO_PLE 1
#endif
constexpr int NPHASE = 13;

__global__ void __launch_bounds__(NTHR, 2) fwd_kernel(Params P) {
    extern __shared__ __attribute__((aligned(16))) unsigned char lds_raw[];
    LAS unsigned char* lds = (LAS unsigned char*)lds_raw;
    LAS int* lctl = (LAS int*)(lds + LDSCTL_OFF);
    const int WID = __builtin_amdgcn_readfirstlane((int)threadIdx.x >> 6);
    for (int u = opaque_tid(); u < (LDS_BYTES - LDSCTL_OFF) / 4; u += NTHR) ((LAS unsigned*)(lds + LDSCTL_OFF))[u] = 0u;
    __syncthreads();
    unsigned* ctl = (unsigned*)(P.ws + WS_CTL);
    XcdBarrier bar; bar.bar = ctl + CW_BAR; bar.x = 0; bar.st = nullptr; bar.wid = WID;
    const bool one_launch = (P.ph_hi - P.ph_lo) > 1;
    if (one_launch) bar = xcd_barrier_post(ctl + CW_BAR, (volatile LAS unsigned*)(lds + LC_MISC) + 8, WID);
    const int lo = P.ph_lo, hi = P.ph_hi;
#define IN(k) (lo <= (k) && (k) < hi)
#define SEAM(k) do { if (IN(k) && IN((k) + 1)) xcd_barrier(bar); } while (0)
    const int c = blockIdx.x, G = gridDim.x;

    if (IN(0)) { prologue_phase(P, lds, WID); }
    SEAM(0);
    if (IN(1)) {
#if DO_MIXER
        gemm_phase<GP_INPROJ, false>(P, lds, lctl, WID);
#endif
#if DO_PLE
        gemm_phase<GP_PP, false>(P, lds, lctl, WID);
#endif
    }
    SEAM(1);
    if (IN(2)) {
#if DO_MIXER
#if DO_ATTN
        for (int k = 0; k < 2; ++k) { const int item = k == 0 ? c : 511 - c; if (c < 256 && item < 512) indexer_item(P, lds, item, WID); __syncthreads(); }
        for (int item = 512 + c; item < 512; item += G) indexer_item(P, lds, item, WID);
#endif
#if DO_HG
        for (int ci = c; ci < 1024; ci += G) hg_pass1(P, lds, ci, WID);
#endif
#endif
    }
    SEAM(2);
    if (IN(3)) {
#if DO_MIXER && DO_HG
        hg_scan(P, WID);
#endif
    }
    SEAM(3);
    if (IN(4)) {
#if DO_MIXER
#if DO_ATTN
        { const int wave = WID; for (int it = c; it < 256; it += G) { const int bh = it >> 3, j = it & 7, a = 8 * j + wave; attn_tile(P, bh >> 3, bh & 7, a, WID); attn_tile(P, bh >> 3, bh & 7, 127 - a, WID); } }
        __syncthreads();
#endif
#if DO_HG
        for (int ci = c; ci < 1024; ci += G) hg_pass3(P, lds, ci, WID);
#endif
#endif
    }
    SEAM(4);
    if (IN(5)) {
#if DO_MIXER
        gemm_phase<GP_MIX, false>(P, lds, lctl, WID);
#endif
    }
    SEAM(5);
    if (IN(6)) {
#if DO_MIXER
        gemm_phase<GP_OUT, false>(P, lds, lctl, WID);
#else
        copy_x_phase(P, WID);
#endif
#if DO_MOE
        __syncthreads();
        expert_convert_phase(P, lds, WID);
#endif
    }
    SEAM(6);
    if (IN(7)) {
#if DO_MOE
        router_phase(P, lds, WID);
#endif
    }
    SEAM(7);
    if (IN(8)) {
#if DO_MOE
        moe_tables(P, lctl, WID); gemm_phase<GP_GU, true>(P, lds, lctl, WID);
#endif
    }
    SEAM(8);
    if (IN(9)) {
#if DO_MOE
        moe_tables(P, lctl, WID); gemm_phase<GP_DN, false>(P, lds, lctl, WID);
#endif
    }
    SEAM(9);
    if (IN(10)) {
#if DO_MOE
        moe_tables(P, lctl, WID);
#endif
        combine_phase(P, lctl, DO_MOE != 0, WID);
    }
    SEAM(10);
    if (IN(11)) {
#if DO_PLE
        gemm_phase<GP_PLE, false>(P, lds, lctl, WID);
#endif
    }
    SEAM(11);
    if (IN(12)) { final_norm_phase(P, WID); }
#undef IN
#undef SEAM
}

extern "C" void kernel_launch(void* const* d_in, const int* in_sizes, int n_in, void* d_out, int out_size, void* d_ws, size_t ws_size, hipStream_t stream) {
    static int grid = 0;
    if (grid == 0) {
        if (n_in != 22 || out_size != NTOK * D || ws_size < WS_NEED) { fprintf(stderr, "kernel_launch: unexpected shapes (n_in %d out %d ws %zu need %zu)\n", n_in, out_size, ws_size, (size_t)WS_NEED); grid = -1; return; }
        int dev = 0, cus = 0, per_cu = 0;
        if (hipGetDevice(&dev) != hipSuccess || hipDeviceGetAttribute(&cus, hipDeviceAttributeMultiprocessorCount, dev) != hipSuccess) { grid = -1; return; }
        if (hipFuncSetAttribute((const void*)fwd_kernel, hipFuncAttributeMaxDynamicSharedMemorySize, LDS_BYTES) != hipSuccess) { fprintf(stderr, "kernel_launch: hipFuncSetAttribute failed\n"); grid = -1; return; }
        if (hipOccupancyMaxActiveBlocksPerMultiprocessor(&per_cu, (const void*)fwd_kernel, NTHR, LDS_BYTES) != hipSuccess || per_cu < 1) fprintf(stderr, "kernel_launch: occupancy query reports %d\n", per_cu);
        (void)hipGetLastError();
        grid = cus;
    }
    if (grid < 0) return;
    (void)hipMemsetAsync((char*)d_ws + WS_CTL, 0, CTL_ZERO_BYTES, stream);
    Params p{};
    const float** f = (const float**)&p;
    for (int i = 0; i < 22; ++i) f[i] = (const float*)d_in[i];
    p.out = (float*)d_out; p.ws = (unsigned char*)d_ws;
#if N_LAUNCH_MODE == 1
    p.ph_lo = 0; p.ph_hi = NPHASE;
    hipLaunchKernelGGL(fwd_kernel, dim3(grid), dim3(NTHR), LDS_BYTES, stream, p);
#else
    for (int ph = 0; ph < NPHASE; ++ph) { p.ph_lo = ph; p.ph_hi = ph + 1; hipLaunchKernelGGL(fwd_kernel, dim3(grid), dim3(NTHR), LDS_BYTES, stream, p); }
#endif
}
```

```cpp
#include <hip/hip_runtime.h>
#include <cstdio>
#include <cstdint>

#ifndef N_LAUNCH_MODE
#define N_LAUNCH_MODE 1
#endif
#ifndef STAGE
#define STAGE 99
#endif

#define LAS __attribute__((address_space(3)))
#define GAS __attribute__((address_space(1)))
typedef unsigned short bf16_t;
typedef short bf16x8 __attribute__((ext_vector_type(8)));
typedef short s16x4 __attribute__((ext_vector_type(4)));
typedef float f32x2 __attribute__((ext_vector_type(2)));
typedef float f32x4 __attribute__((ext_vector_type(4)));
typedef float f32x16 __attribute__((ext_vector_type(16)));
typedef unsigned u32x4 __attribute__((ext_vector_type(4)));
typedef unsigned u32x2 __attribute__((ext_vector_type(2)));

constexpr int NB = 4, T = 2048, D = 2048, NTOK = NB * T;
constexpr int HGW = 1024, ATW = 1024;
constexpr int D_IN = 12368;
constexpr int NE = 32, DE = 512, PLE = 256;
constexpr int N1 = 11520;
constexpr float RMS_EPS = 1e-6f;
constexpr int NWAVES = 8, NTHR = 512;
constexpr int MAXTILES = 96;

constexpr size_t MiB = 1u << 20;
constexpr size_t WS_CTL = 0, CTL_ZERO_BYTES = 1 * MiB;
constexpr size_t WS_WHG = 1 * MiB, WS_WAT = 5 * MiB, WS_WOUT = 9 * MiB, WS_WPG = 17 * MiB, WS_WPP = 25 * MiB;
constexpr size_t WS_XN = 26 * MiB;
constexpr size_t WS_PP = 58 * MiB;
constexpr size_t WS_PBF = 90 * MiB;
constexpr size_t WS_MASK = 94 * MiB;
constexpr size_t WS_IK = 96 * MiB;
constexpr size_t WS_IW = 97 * MiB;
constexpr size_t WS_GDEC = 97 * MiB + 512 * 1024;
constexpr size_t WS_ROUTE = 98 * MiB;
constexpr size_t WS_LIST = 99 * MiB;
constexpr size_t WS_RSL = 100 * MiB;
constexpr size_t WS_MISC = 101 * MiB;
constexpr size_t WS_BIG = 102 * MiB;
constexpr size_t WS_WIN = WS_BIG;
constexpr size_t WS_WAV = WS_BIG + 45 * MiB;
constexpr size_t WS_QH = WS_BIG + 49 * MiB, WS_KH = WS_QH + 16 * MiB, WS_VH = WS_KH + 16 * MiB, WS_HGO = WS_VH + 16 * MiB;
constexpr size_t WS_AQ = WS_HGO + 16 * MiB, WS_AK = WS_AQ + 16 * MiB, WS_IQ = WS_AK + 16 * MiB, WS_VT = WS_IQ + 16 * MiB;
constexpr size_t WS_LF = WS_VT + 16 * MiB;
constexpr size_t WS_GAB = WS_LF + 32 * MiB;
constexpr size_t WS_U = WS_GAB + 64 * MiB;
constexpr size_t WS_ST = WS_U + 64 * MiB;
constexpr size_t WS_OHG = WS_ST + 32 * MiB, WS_OAT = WS_OHG + 16 * MiB;
constexpr size_t WS_MIXED = WS_OAT + 16 * MiB;
constexpr size_t WS_END1 = WS_MIXED + 32 * MiB;
constexpr size_t WS_WGU = WS_BIG;
constexpr size_t WS_WD = WS_BIG + 128 * MiB;
constexpr size_t WS_HID = WS_BIG + 192 * MiB;
constexpr size_t WS_Y = WS_BIG + 216 * MiB;
static_assert(WS_Y + 96 * MiB <= WS_MIXED, "late overlays stay below MIXED");
constexpr size_t WS_NEED = WS_END1;

constexpr int CW_CNT = 64;
constexpr int CW_BAR = 4096;

constexpr int RING_BYTES = 131072, LDSCTL_OFF = RING_BYTES, LDS_BYTES = 147456;
constexpr int LC_MISC = LDSCTL_OFF;
constexpr int LC_TEXP = LDSCTL_OFF + 256;
constexpr int LC_TB = LDSCTL_OFF + 256 + 384;
constexpr int LC_CNT = LDSCTL_OFF + 256 + 384 + 144;

struct Params {
    const float *x, *p, *attn_norm, *w_in, *b_in, *lb_logits, *hg_out_norm, *w_hg_up, *w_attn_up, *w_out, *ffn_norm, *w_rg, *b_rg, *w_re, *b_re,
        *w_eg, *w_eu, *w_ed, *ple_norm, *w_pg, *w_pp, *final_norm;
    float* out; unsigned char* ws;
    int ph_lo, ph_hi;
};

__device__ __forceinline__ int tid_from(int wid) { int l = __builtin_amdgcn_mbcnt_hi(~0u, __builtin_amdgcn_mbcnt_lo(~0u, 0u)); asm volatile("" : "+v"(l)); return wid * 64 + l; }
#define opaque_tid() tid_from(WID)
__device__ __forceinline__ unsigned cvt_pk_bf16(float lo, float hi) { unsigned r; asm volatile("v_cvt_pk_bf16_f32 %0, %1, %2" : "=v"(r) : "v"(lo), "v"(hi)); return r; }
__device__ __forceinline__ float bf2f(unsigned short h) { return __uint_as_float((unsigned)h << 16); }
__device__ __forceinline__ float bflo(unsigned w) { return __uint_as_float(w << 16); }
__device__ __forceinline__ float bfhi(unsigned w) { return __uint_as_float(w & 0xffff0000u); }
__device__ __forceinline__ float sigmoid_f(float v) { return __builtin_amdgcn_rcpf(1.0f + __expf(-v)); }
__device__ __forceinline__ float silu_f(float v) { return v * sigmoid_f(v); }
__device__ __forceinline__ float wave_sum(float v) {
#pragma unroll
    for (int o = 1; o < 64; o <<= 1) v += __shfl_xor(v, o);
    return v;
}
#define LDS_WAIT() asm volatile("s_waitcnt lgkmcnt(0)" ::: "memory")
#define VM_WAIT() asm volatile("s_waitcnt vmcnt(0)" ::: "memory")

#define XB_TMO      128
#define XB_XCNT(j)  (256  + 64 * (j))
#define XB_XSUB(j)  (1280 + 64 * (j))
#define XB_XGEN(j)  (2304 + 64 * (j))
#define XB_TOP      3328
#define XB_TOPGEN   3392
#define XCD_BAR_WORDS 3456
#define XB_SPIN_CAP (1u << 18)
__device__ __forceinline__ unsigned xb_ld(unsigned* p)              { return __hip_atomic_load(p, __ATOMIC_RELAXED, __HIP_MEMORY_SCOPE_AGENT); }
__device__ __forceinline__ unsigned xb_add(unsigned* p, unsigned v) { return __hip_atomic_fetch_add(p, v, __ATOMIC_RELAXED, __HIP_MEMORY_SCOPE_AGENT); }
__device__ __forceinline__ unsigned xb_xcc_id() { return (unsigned)__builtin_amdgcn_s_getreg((3 << 11) | 20) & 0xFu; }
#define XB_SPIN(cond, bar) do { unsigned _sp = 0; while (cond) { __builtin_amdgcn_s_sleep(1); \
    if ((++_sp & 255u) == 0u) { if (xb_ld(&(bar)[XB_TMO])) break; if (_sp > XB_SPIN_CAP) { atomicAdd(&(bar)[XB_TMO], 1u); break; } } } } while (0)
struct XcdBarrier { unsigned* bar; unsigned x; volatile LAS unsigned* st; int wid; };
__device__ __forceinline__ XcdBarrier xcd_barrier_post(unsigned* bar, volatile LAS unsigned* st, int WID) {
    XcdBarrier b; b.bar = bar; b.x = xb_xcc_id(); b.st = st; b.wid = WID;
    if (opaque_tid() == 0) (void)xb_add(&bar[XB_XCNT(b.x)], 1u);
    return b;
}
__device__ __forceinline__ void xcd_barrier_complete(unsigned* bar, unsigned x, unsigned& nloc, unsigned& nx) {
    const unsigned G = gridDim.x * gridDim.y * gridDim.z;
    unsigned sum, cnt, mine, sp = 0u;
    for (;;) {
        sum = 0u; cnt = 0u; mine = 0u;
#pragma unroll
        for (unsigned j = 0; j < 16; ++j) { const unsigned c = xb_ld(&bar[XB_XCNT(j)]); sum += c; cnt += (c > 0u) ? 1u : 0u; mine = (j == x) ? c : mine; }
        if (sum == G) break;
        __builtin_amdgcn_s_sleep(1);
        if ((++sp & 255u) == 0u) { if (xb_ld(&bar[XB_TMO])) break; if (sp > XB_SPIN_CAP) { atomicAdd(&bar[XB_TMO], 1u); break; } }
    }
    nloc = mine > 0u ? mine : 1u; nx = cnt > 0u ? cnt : 1u;
}
__device__ __forceinline__ void xcd_barrier(const XcdBarrier& b) {
    asm volatile("s_waitcnt vmcnt(0)" ::: "memory");
    __syncthreads();
    if (tid_from(b.wid) == 0) {
        unsigned* bar = b.bar;
        __builtin_amdgcn_s_waitcnt(0);
        unsigned nloc = b.st[0], nx = b.st[1];
        if (nloc == 0u) { xcd_barrier_complete(bar, b.x, nloc, nx); b.st[0] = nloc; b.st[1] = nx; }
        const unsigned old = xb_add(&bar[XB_XSUB(b.x)], 1u);
        const unsigned gen = old / nloc;
        if (old + 1u == (gen + 1u) * nloc) {
            __builtin_amdgcn_fence(__ATOMIC_RELEASE, "agent");
            asm volatile("s_waitcnt vmcnt(0)" ::: "memory");
            const unsigned og = xb_add(&bar[XB_TOP], 1u);
            const unsigned tg = og / nx;
            if (og + 1u == (tg + 1u) * nx) xb_add(&bar[XB_TOPGEN], 1u);
            else XB_SPIN(xb_ld(&bar[XB_TOPGEN]) == tg, bar);
            __builtin_amdgcn_fence(__ATOMIC_ACQUIRE, "agent");
            xb_add(&bar[XB_XGEN(b.x)], 1u);
            asm volatile("s_waitcnt vmcnt(0)" ::: "memory");
        } else {
            XB_SPIN(xb_ld(&bar[XB_XGEN(b.x)]) == gen, bar);
            __builtin_amdgcn_fence(__ATOMIC_ACQUIRE, "agent");
            asm volatile("s_waitcnt vmcnt(0)" ::: "memory");
        }
    }
    __syncthreads();
}

constexpr int BM = 256, BK = 64, HALF = 128, HTB = HALF * BK * 2;
__device__ __forceinline__ void stage_rc(int b, int& R, int& C) { const int st = b / 1024, sb = b % 1024, swz = sb ^ (((sb >> 9) & 1) << 5); R = (st >> 1) * 16 + swz / 64; C = (st & 1) * 32 + (swz % 64) / 2; }
__device__ __forceinline__ int lds_byte(int r, int c) { const int st = (r >> 4) * 2 + (c >> 5), rr = r & 15, cc = c & 31, ob = rr * 64 + cc * 2; return st * 1024 + (ob ^ (((ob >> 9) & 1) << 5)); }
__device__ __forceinline__ int perm32(int rho) { const int n = rho >> 4, i = rho & 15; return 8 * (i >> 2) + 4 * n + (i & 3); }

enum GemmPhase { GP_INPROJ = 0, GP_MIX = 1, GP_OUT = 2, GP_GU = 3, GP_DN = 4, GP_PLE = 5, GP_PP = 6 };
enum EpiMode { E_SILU = 0, E_HF = 1, E_BF16 = 2, E_AQ = 3, E_SIG = 4, E_IKW = 5, E_VT = 6, E_PP = 7, E_MIX1 = 8, E_MIX2 = 9, E_X1 = 10, E_HID = 11, E_Y = 12, E_PLEG = 13 };

struct GU {
    const char* A; const char* B;
    const int* gidx;
    int lda, ldb;
    int nt;
    int mode, pm, pn, ex, gcnt;
};

__device__ __forceinline__ void map_tile(int L, int nM, int nN, int& pm, int& pn) {
    const int nwg = nM * nN; int wgid = L;
    { const int q = nwg / 8, r = nwg % 8, xcd = wgid % 8, off = wgid / 8; wgid = (xcd < r ? xcd * (q + 1) : r * (q + 1) + (xcd - r) * q) + off; }
    const int nig = 8 * nN, gid = wgid / nig, fm = gid * 8, gsz = (nM - fm) < 8 ? (nM - fm) : 8;
    pm = fm + ((wgid % nig) % gsz); pn = (wgid % nig) / gsz;
}

__device__ __forceinline__ bool unit_next(const Params& P, int ph, int i, int c, int G, const LAS int* lctl, GU& u) {
    unsigned char* ws = P.ws;
    u.gidx = nullptr; u.gcnt = 0; u.ex = 0;
    if (ph == GP_INPROJ) {
        const int L = i * G + c;
        if (L < 1440) {
            map_tile(L, 32, 45, u.pm, u.pn);
            u.A = (const char*)(ws + WS_XN) + (size_t)u.pm * 256 * 4096; u.lda = 4096;
            u.B = (const char*)(ws + WS_WIN) + (size_t)u.pn * 256 * 4096; u.ldb = 4096; u.nt = 32;
            const int pn = u.pn;
            u.mode = pn < 4 ? E_SILU : pn < 8 ? E_HF : pn < 12 ? E_BF16 : pn < 16 ? E_SILU : pn < 20 ? E_AQ : pn < 28 ? E_BF16 : pn < 44 ? E_SIG : E_IKW;
            return true;
        }
        if (L < 1568) {
            const int l = L - 1440; u.pm = l & 3; u.pn = l >> 2;
            u.A = (const char*)(ws + WS_WAV) + (size_t)u.pm * 256 * 4096; u.lda = 4096;
            u.B = (const char*)(ws + WS_XN) + (size_t)u.pn * 256 * 4096; u.ldb = 4096; u.nt = 32; u.mode = E_VT; return true;
        }
        return false;
    }
    if (ph == GP_PP) {
        const int l = i * G + c; if (l >= 256) return false;
        u.pm = l >> 3; u.pn = l & 7;
        u.A = (const char*)(ws + WS_PBF) + (size_t)u.pm * 256 * 512; u.lda = 512;
        u.B = (const char*)(ws + WS_WPP) + (size_t)u.pn * 256 * 512; u.ldb = 512; u.nt = 4; u.mode = E_PP; return true;
    }
    if (ph == GP_MIX) {
        const int tl = (i >> 1) * G + c; if (tl >= 256) return false;
        map_tile(tl, 32, 8, u.pm, u.pn);
        const size_t asrc = (i & 1) ? WS_OAT : WS_OHG, bsrc = (i & 1) ? WS_WAT : WS_WHG;
        u.A = (const char*)(ws + asrc) + (size_t)u.pm * 256 * 2048; u.lda = 2048;
        u.B = (const char*)(ws + bsrc) + (size_t)u.pn * 256 * 2048; u.ldb = 2048; u.nt = 16; u.mode = (i & 1) ? E_MIX2 : E_MIX1; return true;
    }
    if (ph == GP_OUT || ph == GP_PLE) {
        const int L = i * G + c; if (L >= 256) return false;
        map_tile(L, 32, 8, u.pm, u.pn);
        u.A = (const char*)(ws + (ph == GP_OUT ? WS_MIXED : WS_XN)) + (size_t)u.pm * 256 * 4096; u.lda = 4096;
        u.B = (const char*)(ws + (ph == GP_OUT ? WS_WOUT : WS_WPG)) + (size_t)u.pn * 256 * 4096; u.ldb = 4096; u.nt = 32; u.mode = ph == GP_OUT ? E_X1 : E_PLEG; return true;
    }
    if (ph == GP_GU) {
        const int L = i * G + c, ntiles = lctl[(LC_TB - LDSCTL_OFF) / 4 + 32];
        if (L >= ntiles * 4) return false;
        const int tile = L >> 2; u.pn = L & 3; u.pm = tile;
        const int e = lctl[(LC_TEXP - LDSCTL_OFF) / 4 + tile]; u.ex = e;
        const int r0 = (tile - lctl[(LC_TB - LDSCTL_OFF) / 4 + e]) * 256;
        u.gidx = (const int*)(ws + WS_LIST) + e * 8192 + r0; u.gcnt = lctl[(LC_CNT - LDSCTL_OFF) / 4 + e] - r0;
        u.A = (const char*)(ws + WS_XN); u.lda = 4096;
        u.B = (const char*)(ws + WS_WGU) + ((size_t)e * 1024 + (size_t)u.pn * 256) * 4096; u.ldb = 4096; u.nt = 32; u.mode = E_HID; return true;
    }
    if (ph == GP_DN) {
        const int L = i * G + c, ntiles = lctl[(LC_TB - LDSCTL_OFF) / 4 + 32];
        if (L >= ntiles * 8) return false;
        const int tile = L >> 3; u.pn = L & 7; u.pm = tile;
        const int e = lctl[(LC_TEXP - LDSCTL_OFF) / 4 + tile]; u.ex = e;
        u.A = (const char*)(ws + WS_HID) + (size_t)tile * 256 * 1024; u.lda = 1024;
        u.B = (const char*)(ws + WS_WD) + ((size_t)e * 2048 + (size_t)u.pn * 256) * 1024; u.ldb = 1024; u.nt = 8; u.mode = E_Y; return true;
    }
    return false;
}

__device__ __forceinline__ u32x4 pack8(const f32x4 a, const f32x4 b) { u32x4 w; w.x = cvt_pk_bf16(a[0], a[1]); w.y = cvt_pk_bf16(a[2], a[3]); w.z = cvt_pk_bf16(b[0], b[1]); w.w = cvt_pk_bf16(b[2], b[3]); return w; }
__device__ __forceinline__ void unpack8(const u32x4 w, f32x4& a, f32x4& b) { a = (f32x4){bflo(w.x), bfhi(w.x), bflo(w.y), bfhi(w.y)}; b = (f32x4){bflo(w.z), bfhi(w.z), bflo(w.w), bfhi(w.w)}; }

__device__ __forceinline__ bool gemm_epilogue(const Params& P, const GU& u, f32x4 (&acc)[2][2][4][2], int WID) {
    unsigned char* ws = P.ws;
    const int lane_ = opaque_tid() & 63, wr = WID >> 2, wc = WID & 3, fr = lane_ & 15, fq = lane_ >> 4;
    const int rb = u.pm * 256 + wr * 64 + fr;
    const int ct = wc * 32 + 8 * fq;
    const int mode = u.mode;
    if (mode == E_SILU || mode == E_BF16 || mode == E_AQ || mode == E_SIG || mode == E_PP || mode == E_Y) {
        bf16_t* dst; int ldo; const float* bias = nullptr; int cd;
        if (mode == E_PP) { dst = (bf16_t*)(ws + WS_PP); ldo = D; cd = u.pn * 256; }
        else if (mode == E_Y) { dst = (bf16_t*)(ws + WS_Y); ldo = D; cd = u.pn * 256; }
        else {
            const int pn = u.pn; bias = (const float*)(ws + WS_MISC) + pn * 256;
            if (pn < 4) { dst = (bf16_t*)(ws + WS_QH); ldo = 1024; cd = pn * 256; }
            else if (pn < 12) { dst = (bf16_t*)(ws + WS_VH); ldo = 1024; cd = (pn - 8) * 256; }
            else if (pn < 16) { dst = (bf16_t*)(ws + WS_HGO); ldo = 1024; cd = (pn - 12) * 256; }
            else if (pn < 20) { dst = (bf16_t*)(ws + WS_AQ); ldo = 1024; cd = (pn - 16) * 256; }
            else if (pn < 24) { dst = (bf16_t*)(ws + WS_AK); ldo = 1024; cd = (pn - 20) * 256; }
            else if (pn < 28) { dst = (bf16_t*)(ws + WS_IQ); ldo = 1024; cd = (pn - 24) * 256; }
            else { dst = (bf16_t*)(ws + WS_GAB); ldo = 4096; cd = (pn - 28) * 256; }
        }
        const float sc = (mode == E_AQ) ? 0.08838834764831845f * 1.4426950408889634f : 1.0f;
#pragma unroll
        for (int bj = 0; bj < 2; ++bj) {
            f32x4 b0 = (f32x4){0.f, 0.f, 0.f, 0.f}, b1 = b0;
            if (bias) { b0 = *(const f32x4*)(bias + ct + bj * 128); b1 = *(const f32x4*)(bias + ct + bj * 128 + 4); }
#pragma unroll
            for (int ai = 0; ai < 2; ++ai)
#pragma unroll
                for (int m = 0; m < 4; ++m) {
                    f32x4 v0 = acc[ai][bj][m][0] + b0, v1 = acc[ai][bj][m][1] + b1;
                    if (mode == E_SILU) {
#pragma unroll
                        for (int e = 0; e < 4; ++e) { v0[e] = silu_f(v0[e]); v1[e] = silu_f(v1[e]); }
                    } else if (mode == E_SIG) {
#pragma unroll
                        for (int e = 0; e < 4; ++e) { v0[e] = sigmoid_f(v0[e]); v1[e] = sigmoid_f(v1[e]); }
                    } else if (mode == E_AQ) { v0 = v0 * sc; v1 = v1 * sc; }
                    const int row = rb + ai * 128 + m * 16;
                    *(u32x4*)(dst + (size_t)row * ldo + cd + ct + bj * 128) = pack8(v0, v1);
                }
        }
        return false;
    }
    if (mode == E_HF) {
        const int pn = u.pn; const float* bias = (const float*)(ws + WS_MISC) + pn * 256;
        const float* lbp = (const float*)(ws + WS_MISC + 65536) + (pn - 4) * 256;
        bf16_t* kh = (bf16_t*)(ws + WS_KH); float* lf = (float*)(ws + WS_LF); const int cd = (pn - 4) * 256;
#pragma unroll
        for (int bj = 0; bj < 2; ++bj) {
            const f32x4 b0 = *(const f32x4*)(bias + ct + bj * 128), b1 = *(const f32x4*)(bias + ct + bj * 128 + 4);
            const f32x4 l0 = *(const f32x4*)(lbp + ct + bj * 128), l1 = *(const f32x4*)(lbp + ct + bj * 128 + 4);
#pragma unroll
            for (int ai = 0; ai < 2; ++ai)
#pragma unroll
                for (int m = 0; m < 4; ++m) {
                    const f32x4 z0 = acc[ai][bj][m][0] + b0, z1 = acc[ai][bj][m][1] + b1; f32x4 k0, k1, g0, g1;
#pragma unroll
                    for (int e = 0; e < 4; ++e) {
                        const float s0 = sigmoid_f(z0[e]), s1 = sigmoid_f(z1[e]);
                        k0[e] = (1.f - l0[e]) * (1.f - s0); k1[e] = (1.f - l1[e]) * (1.f - s1);
                        g0[e] = __logf(l0[e] + (1.f - l0[e]) * s0); g1[e] = __logf(l1[e] + (1.f - l1[e]) * s1);
                    }
                    const int row = rb + ai * 128 + m * 16; const size_t o = (size_t)row * 1024 + cd + ct + bj * 128;
                    *(u32x4*)(kh + o) = pack8(k0, k1); *(f32x4*)(lf + o) = g0; *(f32x4*)(lf + o + 4) = g1;
                }
        }
        return false;
    }
    if (mode == E_IKW) {
        const float* bias = (const float*)(ws + WS_MISC) + 44 * 256;
        bf16_t* ik = (bf16_t*)(ws + WS_IK); float* iw = (float*)(ws + WS_IW);
        if (ct < 80) {
            const f32x4 b0 = *(const f32x4*)(bias + ct), b1 = *(const f32x4*)(bias + ct + 4);
#pragma unroll
            for (int ai = 0; ai < 2; ++ai)
#pragma unroll
                for (int m = 0; m < 4; ++m) {
                    const f32x4 v0 = acc[ai][0][m][0] + b0, v1 = acc[ai][0][m][1] + b1; const int row = rb + ai * 128 + m * 16;
                    if (ct < 64) *(u32x4*)(ik + (size_t)row * 64 + ct) = pack8(v0, v1);
                    else { *(f32x4*)(iw + (size_t)row * 16 + (ct - 64)) = v0 * 0.03125f; *(f32x4*)(iw + (size_t)row * 16 + (ct - 64) + 4) = v1 * 0.03125f; }
                }
        }
        return false;
    }
    if (mode == E_VT) {
        const float* bav = (const float*)(ws + WS_MISC + 524288); bf16_t* vt = (bf16_t*)(ws + WS_VT);
#pragma unroll
        for (int ai = 0; ai < 2; ++ai)
#pragma unroll
            for (int m = 0; m < 4; ++m) {
                const int row = rb + ai * 128 + m * 16; const float b = bav[row];
#pragma unroll
                for (int bj = 0; bj < 2; ++bj) { const f32x4 v0 = acc[ai][bj][m][0] + b, v1 = acc[ai][bj][m][1] + b;
                    *(u32x4*)(vt + (size_t)row * NTOK + u.pn * 256 + ct + bj * 128) = pack8(v0, v1); }
            }
        return false;
    }
    if (mode == E_MIX1 || mode == E_MIX2) {
        const bf16_t* gab = (const bf16_t*)(ws + WS_GAB) + (mode == E_MIX2 ? 2048 : 0); bf16_t* mixed = (bf16_t*)(ws + WS_MIXED);
#pragma unroll
        for (int ai = 0; ai < 2; ++ai)
#pragma unroll
            for (int m = 0; m < 4; ++m) {
                const int row = rb + ai * 128 + m * 16;
#pragma unroll
                for (int bj = 0; bj < 2; ++bj) {
                    const int col = u.pn * 256 + ct + bj * 128; f32x4 g0, g1;
                    unpack8(*(const u32x4*)(gab + (size_t)row * 4096 + col), g0, g1);
                    f32x4 v0 = acc[ai][bj][m][0] * g0, v1 = acc[ai][bj][m][1] * g1;
                    if (mode == E_MIX2) { f32x4 t0, t1; unpack8(*(const u32x4*)(mixed + (size_t)row * D + col), t0, t1); v0 = v0 + t0; v1 = v1 + t1; }
                    *(u32x4*)(mixed + (size_t)row * D + col) = pack8(v0, v1);
                }
                asm volatile("" ::: "memory");
            }
        return false;
    }
    if (mode == E_X1) {
#pragma unroll
        for (int ai = 0; ai < 2; ++ai)
#pragma unroll
            for (int m = 0; m < 4; ++m) {
                const int row = rb + ai * 128 + m * 16;
#pragma unroll
                for (int bj = 0; bj < 2; ++bj) { const size_t o = (size_t)row * D + u.pn * 256 + ct + bj * 128;
                    *(f32x4*)(P.out + o) = *(const f32x4*)(P.x + o) + acc[ai][bj][m][0]; *(f32x4*)(P.out + o + 4) = *(const f32x4*)(P.x + o + 4) + acc[ai][bj][m][1]; }
            }
        return false;
    }
    if (mode == E_HID) {
        const float* rsl = (const float*)(ws + WS_RSL) + u.ex * 8192 + (u.gidx - ((const int*)(ws + WS_LIST) + u.ex * 8192));
        bf16_t* hid = (bf16_t*)(ws + WS_HID);
#pragma unroll
        for (int ai = 0; ai < 2; ++ai)
#pragma unroll
            for (int m = 0; m < 4; ++m) {
                const int rl = wr * 64 + fr + ai * 128 + m * 16; const float rs = rl < u.gcnt ? rsl[rl] : 0.f; f32x4 h0, h1;
#pragma unroll
                for (int e = 0; e < 4; ++e) { h0[e] = silu_f(rs * acc[ai][0][m][0][e]) * (rs * acc[ai][1][m][0][e]); h1[e] = silu_f(rs * acc[ai][0][m][1][e]) * (rs * acc[ai][1][m][1][e]); }
                *(u32x4*)(hid + (size_t)(u.pm * 256 + rl) * 512 + u.pn * 128 + ct) = pack8(h0, h1);
            }
        return false;
    }
    if (mode == E_PLEG) {
        const float* rs3 = (const float*)(ws + WS_MISC + 655360); const bf16_t* pp = (const bf16_t*)(ws + WS_PP);
#pragma unroll
        for (int ai = 0; ai < 2; ++ai)
#pragma unroll
            for (int m = 0; m < 4; ++m) {
                const int row = rb + ai * 128 + m * 16; const float rs = rs3[row];
#pragma unroll
                for (int bj = 0; bj < 2; ++bj) { const size_t o = (size_t)row * D + u.pn * 256 + ct + bj * 128; f32x4 p0, p1; unpack8(*(const u32x4*)(pp + o), p0, p1);
                    f32x4 x0 = *(const f32x4*)(P.out + o), x1 = *(const f32x4*)(P.out + o + 4);
#pragma unroll
                    for (int e = 0; e < 4; ++e) { x0[e] += sigmoid_f(rs * acc[ai][bj][m][0][e]) * p0[e]; x1[e] += sigmoid_f(rs * acc[ai][bj][m][1][e]) * p1[e]; }
                    *(f32x4*)(P.out + o) = x0; *(f32x4*)(P.out + o + 4) = x1; }
            }
        return false;
    }
    return false;
}

__device__ __forceinline__ void lane_offsets(int lda, int ldb, int tid, unsigned (&vA)[2], unsigned (&vB)[2]) {
#pragma unroll
    for (int i = 0; i < 2; ++i) {
        int R, C; stage_rc(tid * 16 + i * 8192, R, C);
        const int Rb = (R & ~31) + perm32(R & 31);
        vB[i] = (unsigned)(Rb * ldb + C * 2); vA[i] = (unsigned)(R * lda + C * 2);
    }
}
__device__ __forceinline__ void gather_offsets(const GU& u, int tid, unsigned (&g0)[2], unsigned (&g1)[2]) {
#pragma unroll
    for (int i = 0; i < 2; ++i) {
        int R, C; stage_rc(tid * 16 + i * 8192, R, C);
        const int r0 = (R < u.gcnt) ? u.gidx[R] : 0, r1 = (R + 128 < u.gcnt) ? u.gidx[R + 128] : 0;
        g0[i] = (unsigned)(r0 * u.lda + C * 2); g1[i] = (unsigned)(r1 * u.lda + C * 2);
    }
}

template <int PH, bool GATHER>
__device__ __forceinline__ void gemm_phase(const Params& P, LAS unsigned char* lds, const LAS int* lctl, int WID) {
    const int tid = opaque_tid(), wid = __builtin_amdgcn_readfirstlane(tid >> 6), lane = tid & 63, wr = wid >> 2, wc = wid & 3, fr = lane & 15, fq = lane >> 4;
    const int G = gridDim.x, c = blockIdx.x;
    const size_t kstep = (size_t)(BK * 2);
    const unsigned ldsw = (unsigned)wid * 1024u;
    const int aoff = lds_byte(wr * 64 + fr, fq * 8), boff = lds_byte(wc * 32 + fr, fq * 8);
#define PG8_SA(b, h) (((b) * 2 + (h)) * HTB)
#define PG8_SB(b, h) ((4 + (b) * 2 + (h)) * HTB)
#define PG8_STAGE(bufoff, gbase, voff) do { _Pragma("unroll") for (int _i = 0; _i < 2; ++_i) \
        __builtin_amdgcn_global_load_lds((const unsigned*)((const char*)(gbase) + (voff)[_i]), (LAS unsigned*)(lds + (bufoff) + ldsw + _i * 8192), 16, 0, 0); } while (0)
#define PG8_LDA(dst, b, h) do { _Pragma("unroll") for (int m = 0; m < 4; ++m) _Pragma("unroll") for (int k = 0; k < 2; ++k) dst[m][k] = *(const LAS bf16x8*)(lds + PG8_SA(b, h) + aoff + m * 2048 + k * 1024); } while (0)
#define PG8_LDB(dst, b, h) do { _Pragma("unroll") for (int n = 0; n < 2; ++n) _Pragma("unroll") for (int k = 0; k < 2; ++k) dst[n][k] = *(const LAS bf16x8*)(lds + PG8_SB(b, h) + boff + n * 2048 + k * 1024); } while (0)
#define PG8_MMA(ai, bj, At, Bt) do { __builtin_amdgcn_s_setprio(1); _Pragma("unroll") for (int m = 0; m < 4; ++m) _Pragma("unroll") for (int n = 0; n < 2; ++n) _Pragma("unroll") for (int k = 0; k < 2; ++k) \
        acc[ai][bj][m][n] = __builtin_amdgcn_mfma_f32_16x16x32_bf16(Bt[n][k], At[m][k], acc[ai][bj][m][n], 0, 0, 0); __builtin_amdgcn_s_setprio(0); } while (0)
#define PG8_WAIT_V(n) asm volatile("s_waitcnt vmcnt(" #n ")" ::: "memory")
#define PG8_WAIT_L(n) asm volatile("s_waitcnt lgkmcnt(" #n ")" ::: "memory")
#define PG8_BAR __builtin_amdgcn_s_barrier()
#define PG8_SCHED __builtin_amdgcn_sched_barrier(0)
    GU cur, nxt; int ui = 0;
    if (!unit_next(P, PH, 0, c, G, lctl, cur)) return;
    f32x4 acc[2][2][4][2];
#pragma unroll
    for (int a = 0; a < 2; ++a)
#pragma unroll
        for (int b = 0; b < 2; ++b)
#pragma unroll
            for (int m = 0; m < 4; ++m)
#pragma unroll
                for (int n = 0; n < 2; ++n) acc[a][b][m][n] = (f32x4){0.f, 0.f, 0.f, 0.f};
    bf16x8 At[4][2], B0[2][2], B1[2][2];
    const int nt = cur.nt;
    const size_t hB = (size_t)128 * cur.ldb, hA = GATHER ? (size_t)0 : (size_t)128 * cur.lda;
    unsigned vA[2], vB[2], vA1[2], nA0[2], nA1[2];
    lane_offsets(cur.lda, cur.ldb, tid, vA, vB);
    if (GATHER) gather_offsets(cur, tid, vA, vA1);
    const char* cA = cur.A; const char* cB = cur.B;
#define VA1 (GATHER ? vA1 : vA)
    PG8_STAGE(PG8_SB(0, 0), cB, vB); PG8_STAGE(PG8_SB(0, 1), cB + hB, vB); PG8_STAGE(PG8_SA(0, 0), cA, vA); PG8_STAGE(PG8_SA(0, 1), cA + hA, VA1);
    if (wr == 1) PG8_BAR;
    PG8_WAIT_V(2); PG8_BAR;
    PG8_STAGE(PG8_SB(1, 0), cB + kstep, vB); PG8_STAGE(PG8_SA(1, 0), cA + kstep, vA); PG8_STAGE(PG8_SB(1, 1), cB + hB + kstep, vB);
    PG8_WAIT_V(6); PG8_BAR;
    for (;;) {
        const bool has_next = unit_next(P, PH, ui + 1, c, G, lctl, nxt);
        const char* nA = has_next ? nxt.A : cA; const char* nB = has_next ? nxt.B : cB;
        if (GATHER) {
            if (has_next) gather_offsets(nxt, tid, nA0, nA1);
            else {
#pragma unroll
                for (int i = 0; i < 2; ++i) { nA0[i] = vA[i]; nA1[i] = vA1[i]; }
            }
        }
        for (int t = 0; t < nt; t += 2) {
            const bool last = (t == nt - 2);
            const char* a1 = cA + (size_t)(t + 1) * kstep;
            const char* a2 = last ? nA : cA + (size_t)(t + 2) * kstep; const char* b2 = last ? nB : cB + (size_t)(t + 2) * kstep;
            const char* a3 = a2 + kstep; const char* b3 = b2 + kstep;
            unsigned sA0[2], sA1[2];
#pragma unroll
            for (int i = 0; i < 2; ++i) { sA0[i] = (GATHER && last) ? nA0[i] : vA[i]; sA1[i] = GATHER ? (last ? nA1[i] : vA1[i]) : vA[i]; }
            PG8_LDB(B0, 0, 0); PG8_LDB(B1, 0, 1); PG8_SCHED; PG8_LDA(At, 0, 0); PG8_STAGE(PG8_SA(1, 1), a1 + hA, VA1);
            PG8_WAIT_V(8); PG8_WAIT_L(0); PG8_BAR; PG8_MMA(0, 0, At, B0); PG8_MMA(0, 1, At, B1); PG8_BAR; PG8_SCHED;
            PG8_LDA(At, 0, 1); PG8_STAGE(PG8_SB(0, 0), b2, vB); PG8_STAGE(PG8_SB(0, 1), b2 + hB, vB); PG8_STAGE(PG8_SA(0, 0), a2, sA0);
            PG8_WAIT_V(8); PG8_WAIT_L(0); PG8_BAR; PG8_MMA(1, 0, At, B0); PG8_MMA(1, 1, At, B1); PG8_BAR; PG8_SCHED;
            PG8_LDB(B0, 1, 0); PG8_LDB(B1, 1, 1); PG8_SCHED; PG8_LDA(At, 1, 0); PG8_STAGE(PG8_SA(0, 1), a2 + hA, sA1);
            PG8_WAIT_V(8); PG8_WAIT_L(0); PG8_BAR; PG8_MMA(0, 0, At, B0); PG8_MMA(0, 1, At, B1); PG8_BAR; PG8_SCHED;
            PG8_LDA(At, 1, 1); PG8_STAGE(PG8_SB(1, 0), b3, vB); PG8_STAGE(PG8_SB(1, 1), b3 + hB, vB); PG8_STAGE(PG8_SA(1, 0), a3, sA0);
            PG8_WAIT_V(8); PG8_WAIT_L(0); PG8_BAR; PG8_MMA(1, 0, At, B0); PG8_MMA(1, 1, At, B1); PG8_BAR; PG8_SCHED;
        }
        if (wr == 0) PG8_BAR;
        const bool keep = gemm_epilogue(P, cur, acc, WID);
        if (!has_next) break;
        if (!keep) {
#pragma unroll
            for (int a = 0; a < 2; ++a)
#pragma unroll
                for (int b = 0; b < 2; ++b)
#pragma unroll
                    for (int m = 0; m < 4; ++m)
#pragma unroll
                        for (int n = 0; n < 2; ++n) acc[a][b][m][n] = (f32x4){0.f, 0.f, 0.f, 0.f};
        }
        cur = nxt; cA = nA; cB = nB; ++ui;
        if (GATHER) {
#pragma unroll
            for (int i = 0; i < 2; ++i) { vA[i] = nA0[i]; vA1[i] = nA1[i]; }
        }
        if (wr == 1) PG8_BAR;
    }
    PG8_WAIT_V(0);
    PG8_BAR;
#undef VA1
#undef PG8_SA
#undef PG8_SB
#undef PG8_STAGE
#undef PG8_LDA
#undef PG8_LDB
#undef PG8_MMA
#undef PG8_WAIT_V
#undef PG8_WAIT_L
#undef PG8_BAR
#undef PG8_SCHED
}

__device__ __forceinline__ void tr_item(const float* W, size_t srcpitch, int scol, int k0, bf16_t* dst, int dK, int drow0, LAS unsigned* scr, int lane) {
    const float* src = W + (size_t)k0 * srcpitch + (scol < 0 ? 0 : scol);
    float v[64];
#pragma unroll
    for (int i = 0; i < 64; ++i) v[i] = (scol >= 0) ? src[(size_t)i * srcpitch] : 0.f;
#pragma unroll
    for (int i = 0; i < 32; ++i) scr[lane * 33 + i] = cvt_pk_bf16(v[2 * i], v[2 * i + 1]);
    LDS_WAIT(); asm volatile("" ::: "memory");
    const int cch = lane & 7;
#pragma unroll
    for (int j = 0; j < 8; ++j) {
        const int n = (lane >> 3) + 8 * j; const LAS unsigned* s = scr + n * 33 + 4 * cch;
        u32x4 o; o.x = s[0]; o.y = s[1]; o.z = s[2]; o.w = s[3];
        *(u32x4*)(dst + (size_t)(drow0 + n) * dK + k0 + 8 * cch) = o;
    }
    LDS_WAIT(); asm volatile("" ::: "memory");
}
__device__ __forceinline__ int win_srccol(int r) {
    if (r < 6144) return r;
    if (r < 7168) return 7168 + (r - 6144);
    if (r < 11264) return 8272 + (r - 7168);
    if (r < 11344) return 8192 + (r - 11264);
    return -1;
}
__device__ __forceinline__ void prologue_phase(const Params& P, LAS unsigned char* lds, int WID) {
    unsigned char* ws = P.ws;
    const int tid = opaque_tid(), lane = tid & 63, wave = tid >> 6;
    const int gw = blockIdx.x * NWAVES + wave, NGW = gridDim.x * NWAVES;
    LAS unsigned* scr = (LAS unsigned*)(lds + wave * 8448);
    constexpr int I_WIN = 32 * 180, I_WAV = 32 * 16, I_HG = 16 * 32, I_AT = 16 * 32, I_OUT = 32 * 32, I_PG = 32 * 32, I_PPJ = 4 * 32;
    constexpr int NIT = I_WIN + I_WAV + I_HG + I_AT + I_OUT + I_PG + I_PPJ;
    for (int it = gw; it < NIT; it += NGW) {
        int r = it;
        if (r < I_WIN) { const int nb = r % 180, kb = r / 180; tr_item(P.w_in, D_IN, win_srccol(nb * 64 + lane), kb * 64, (bf16_t*)(ws + WS_WIN), 2048, nb * 64, scr, lane); continue; } r -= I_WIN;
        if (r < I_WAV) { const int nb = r % 16, kb = r / 16; tr_item(P.w_in, D_IN, 6144 + nb * 64 + lane, kb * 64, (bf16_t*)(ws + WS_WAV), 2048, nb * 64, scr, lane); continue; } r -= I_WAV;
        if (r < I_HG) { const int nb = r % 32, kb = r / 32; tr_item(P.w_hg_up, 2048, nb * 64 + lane, kb * 64, (bf16_t*)(ws + WS_WHG), 1024, nb * 64, scr, lane); continue; } r -= I_HG;
        if (r < I_AT) { const int nb = r % 32, kb = r / 32; tr_item(P.w_attn_up, 2048, nb * 64 + lane, kb * 64, (bf16_t*)(ws + WS_WAT), 1024, nb * 64, scr, lane); continue; } r -= I_AT;
        if (r < I_OUT) { const int nb = r % 32, kb = r / 32; tr_item(P.w_out, 2048, nb * 64 + lane, kb * 64, (bf16_t*)(ws + WS_WOUT), 2048, nb * 64, scr, lane); continue; } r -= I_OUT;
        if (r < I_PG) { const int nb = r % 32, kb = r / 32; tr_item(P.w_pg, 2048, nb * 64 + lane, kb * 64, (bf16_t*)(ws + WS_WPG), 2048, nb * 64, scr, lane); continue; } r -= I_PG;
        { const int nb = r % 32, kb = r / 32; tr_item(P.w_pp, 2048, nb * 64 + lane, kb * 64, (bf16_t*)(ws + WS_WPP), 256, nb * 64, scr, lane); }
    }
    for (int m = gw; m < NTOK; m += NGW) {
        const f32x4* xr = (const f32x4*)(P.x + (size_t)m * D) + lane; f32x4 v[8]; float s = 0.f;
#pragma unroll
        for (int j = 0; j < 8; ++j) { v[j] = xr[64 * j]; s += (v[j][0] * v[j][0] + v[j][1] * v[j][1]) + (v[j][2] * v[j][2] + v[j][3] * v[j][3]); }
        const float rstd = rsqrtf(wave_sum(s) * (1.f / D) + RMS_EPS);
        u32x2* o = (u32x2*)((bf16_t*)(ws + WS_XN) + (size_t)m * D) + lane; const f32x4* g = (const f32x4*)P.attn_norm + lane;
#pragma unroll
        for (int j = 0; j < 8; ++j) { const f32x4 gg = g[64 * j]; u32x2 w; w.x = cvt_pk_bf16(v[j][0] * rstd * gg[0], v[j][1] * rstd * gg[1]); w.y = cvt_pk_bf16(v[j][2] * rstd * gg[2], v[j][3] * rstd * gg[3]); o[64 * j] = w; }
    }
    for (int m = gw; m < NTOK; m += NGW) { const f32x4 v = ((const f32x4*)(P.p + (size_t)m * PLE))[lane]; u32x2 w; w.x = cvt_pk_bf16(v[0], v[1]); w.y = cvt_pk_bf16(v[2], v[3]); ((u32x2*)((bf16_t*)(ws + WS_PBF) + (size_t)m * PLE))[lane] = w; }
    const int gt = blockIdx.x * NTHR + tid, NGT = gridDim.x * NTHR;
    float* binp = (float*)(ws + WS_MISC); float* lb = (float*)(ws + WS_MISC + 65536); float* wrt = (float*)(ws + WS_MISC + 131072); float* bav = (float*)(ws + WS_MISC + 524288);
    for (int i = gt; i < N1; i += NGT) { const int sc = win_srccol(i); binp[i] = sc < 0 ? 0.f : P.b_in[sc]; }
    for (int i = gt; i < 1024; i += NGT) { lb[i] = 1.f / (1.f + __expf(P.lb_logits[1024 + i] - P.lb_logits[i])); bav[i] = P.b_in[6144 + i]; }
    for (int i = gt; i < 48 * 2048; i += NGT) { const int o = i / 2048, k = i % 2048; wrt[i] = o >= 36 ? 0.f : P.ffn_norm[k] * (o < 4 ? P.w_rg[k * 4 + o] : P.w_re[k * 32 + (o - 4)]); }
}

__device__ __forceinline__ void expert_convert_phase(const Params& P, LAS unsigned char* lds, int WID) {
    unsigned char* ws = P.ws;
    const int tid = opaque_tid(), lane = tid & 63, wave = tid >> 6;
    const int gw = blockIdx.x * NWAVES + wave, NGW = gridDim.x * NWAVES;
    LAS unsigned* scr = (LAS unsigned*)(lds + wave * 8448);
    constexpr int PER_E_GU = 32 * 8, PER_E_D = 8 * 32;
    constexpr int NIT = NE * (2 * PER_E_GU + PER_E_D);
    for (int it = gw; it < NIT; it += NGW) {
        const int e = it / (2 * PER_E_GU + PER_E_D); int r = it % (2 * PER_E_GU + PER_E_D);
        if (r < 2 * PER_E_GU) {
            const int up = r >= PER_E_GU; if (up) r -= PER_E_GU;
            const int nb = r % 8, kb = r / 8;
            const int drow = (nb >> 1) * 256 + up * 128 + (nb & 1) * 64;
            tr_item((up ? P.w_eu : P.w_eg) + (size_t)e * 2048 * 512, 512, nb * 64 + lane, kb * 64, (bf16_t*)(ws + WS_WGU) + (size_t)e * 1024 * 2048, 2048, drow, scr, lane);
        } else {
            r -= 2 * PER_E_GU; const int nb = r % 32, kb = r / 32;
            tr_item(P.w_ed + (size_t)e * 512 * 2048, 2048, nb * 64 + lane, kb * 64, (bf16_t*)(ws + WS_WD) + (size_t)e * 2048 * 512, 512, nb * 64, scr, lane);
        }
    }
}

__device__ __forceinline__ void final_norm_phase(const Params& P, int WID) {
    const int tid = opaque_tid(), lane = tid & 63, wave = tid >> 6;
    const int gw = blockIdx.x * NWAVES + wave, NGW = gridDim.x * NWAVES;
    for (int m = gw; m < NTOK; m += NGW) {
        f32x4* xr = (f32x4*)(P.out + (size_t)m * D) + lane; f32x4 v[8]; float s = 0.f;
#pragma unroll
        for (int j = 0; j < 8; ++j) { v[j] = xr[64 * j]; s += (v[j][0] * v[j][0] + v[j][1] * v[j][1]) + (v[j][2] * v[j][2] + v[j][3] * v[j][3]); }
        const float rstd = rsqrtf(wave_sum(s) * (1.f / D) + RMS_EPS); const f32x4* g = (const f32x4*)P.final_norm + lane;
#pragma unroll
        for (int j = 0; j < 8; ++j) xr[64 * j] = v[j] * rstd * g[64 * j];
    }
}
__device__ __forceinline__ void copy_x_phase(const Params& P, int WID) {
    const int gt = blockIdx.x * NTHR + opaque_tid(), NGT = gridDim.x * NTHR;
    for (int i = gt; i < NTOK * D / 4; i += NGT) ((f32x4*)P.out)[i] = ((const f32x4*)P.x)[i];
}

__device__ __forceinline__ void router_phase(const Params& P, LAS unsigned char* lds, int WID) {
    unsigned char* ws = P.ws;
    const int tid = opaque_tid(), lane = tid & 63, c16 = lane & 15, kq = lane >> 4;
    const int ti = WID >> 2, kq4 = WID & 3;
    const float* wrt = (const float*)(ws + WS_MISC + 131072);
    LAS float* red = (LAS float*)lds;
    unsigned* cnt = (unsigned*)(ws + WS_CTL) + CW_CNT;
    for (int item = blockIdx.x * 2 + ti; item < NTOK / 16; item += gridDim.x * 2) {
        const int tok0 = item * 16;
        const float* xr = P.out + (size_t)(tok0 + c16) * D + 512 * kq4 + 4 * kq;
        bf16_t* xo = (bf16_t*)(ws + WS_XN) + (size_t)(tok0 + c16) * D + 512 * kq4 + 4 * kq;
        const float* gr = P.ffn_norm + 512 * kq4 + 4 * kq;
        const float* wr0 = wrt + (size_t)c16 * 2048 + 512 * kq4 + 4 * kq;
        f32x4 acc[3]; acc[0] = (f32x4){0.f, 0.f, 0.f, 0.f}; acc[1] = acc[0]; acc[2] = acc[0];
        float ssq = 0.f;
        f32x4 xv[4], wv[3][4], xn[4], wn[3][4];
#pragma unroll
        for (int j = 0; j < 4; ++j) { const int ko = j * 16; xv[j] = *(const f32x4*)(xr + ko);
#pragma unroll
            for (int ot = 0; ot < 3; ++ot) wv[ot][j] = *(const f32x4*)(wr0 + (size_t)ot * 16 * 2048 + ko); }
#pragma unroll 1
        for (int k4 = 0; k4 < 8; ++k4) {
            const int kn = (k4 + 1 < 8) ? k4 + 1 : 7;
#pragma unroll
            for (int j = 0; j < 4; ++j) { const int ko = (kn * 4 + j) * 16; xn[j] = *(const f32x4*)(xr + ko);
#pragma unroll
                for (int ot = 0; ot < 3; ++ot) wn[ot][j] = *(const f32x4*)(wr0 + (size_t)ot * 16 * 2048 + ko); }
#pragma unroll
            for (int j = 0; j < 4; ++j) {
                const int ko = (k4 * 4 + j) * 16; const f32x4 v = xv[j], gg = *(const f32x4*)(gr + ko);
                ssq += (v[0] * v[0] + v[1] * v[1]) + (v[2] * v[2] + v[3] * v[3]);
                u32x2 w; w.x = cvt_pk_bf16(v[0] * gg[0], v[1] * gg[1]); w.y = cvt_pk_bf16(v[2] * gg[2], v[3] * gg[3]); *(u32x2*)(xo + ko) = w;
#pragma unroll
                for (int e = 0; e < 4; ++e)
#pragma unroll
                    for (int ot = 0; ot < 3; ++ot) acc[ot] = __builtin_amdgcn_mfma_f32_16x16x4f32(wv[ot][j][e], v[e], acc[ot], 0, 0, 0);
            }
#pragma unroll
            for (int j = 0; j < 4; ++j) { xv[j] = xn[j];
#pragma unroll
                for (int ot = 0; ot < 3; ++ot) wv[ot][j] = wn[ot][j]; }
        }
        ssq += __shfl_xor(ssq, 16); ssq += __shfl_xor(ssq, 32);
        LAS float* rp = red + (ti * 4 + kq4) * 49 * 16;
#pragma unroll
        for (int ot = 0; ot < 3; ++ot)
#pragma unroll
            for (int i = 0; i < 4; ++i) rp[(16 * ot + 4 * kq + i) * 16 + c16] = acc[ot][i];
        if (kq == 0) rp[48 * 16 + c16] = ssq;
        __syncthreads();
        if (kq4 == 0 && lane < 16) {
            const LAS float* r0 = red + (ti * 4) * 49 * 16 + lane;
            float l[36];
#pragma unroll
            for (int o = 0; o < 36; ++o) l[o] = (r0[o * 16] + r0[49 * 16 + o * 16]) + (r0[2 * 49 * 16 + o * 16] + r0[3 * 49 * 16 + o * 16]);
            const float sst = (r0[48 * 16] + r0[49 * 16 + 48 * 16]) + (r0[2 * 49 * 16 + 48 * 16] + r0[3 * 49 * 16 + 48 * 16]);
            const float rstd = rsqrtf(sst * (1.f / D) + RMS_EPS);
#pragma unroll
            for (int o = 0; o < 36; ++o) l[o] = l[o] * rstd + (o < 4 ? P.b_rg[o] : P.b_re[o - 4]);
            int gid = 0; float gm = l[0];
#pragma unroll
            for (int o = 1; o < 4; ++o) if (l[o] > gm) { gm = l[o]; gid = o; }
            float gz = 0.f;
#pragma unroll
            for (int o = 0; o < 4; ++o) gz += __expf(l[o] - gm);
            const float pg = 1.f / gz;
            float e[8];
#pragma unroll
            for (int k = 0; k < 8; ++k) e[k] = gid == 0 ? l[4 + k] : gid == 1 ? l[12 + k] : gid == 2 ? l[20 + k] : l[28 + k];
            int i1 = 0; float m1 = e[0];
#pragma unroll
            for (int k = 1; k < 8; ++k) if (e[k] > m1) { m1 = e[k]; i1 = k; }
            int i2 = 0; float m2 = -INFINITY;
#pragma unroll
            for (int k = 0; k < 8; ++k) if (k != i1 && e[k] > m2) { m2 = e[k]; i2 = k; }
            const float r = __expf(m2 - m1), w1 = pg / (1.f + r), w2 = pg * r / (1.f + r);
            const int tok = tok0 + lane, e1 = gid * 8 + i1, e2 = gid * 8 + i2;
            const int p1 = (int)atomicAdd(cnt + e1, 1u), p2 = (int)atomicAdd(cnt + e2, 1u);
            int* route = (int*)(ws + WS_ROUTE) + tok * 8;
            route[0] = e1; route[1] = p1; route[2] = e2; route[3] = p2; ((float*)route)[4] = w1; ((float*)route)[5] = w2;
            ((int*)(ws + WS_LIST))[e1 * 8192 + p1] = tok; ((int*)(ws + WS_LIST))[e2 * 8192 + p2] = tok;
            ((float*)(ws + WS_RSL))[e1 * 8192 + p1] = rstd; ((float*)(ws + WS_RSL))[e2 * 8192 + p2] = rstd;
        }
        __syncthreads();
    }
}
__device__ __forceinline__ void moe_tables(const Params& P, LAS int* lctl, int WID) {
    if (WID == 0) {
        const int lane = opaque_tid(); const unsigned* cnt = (const unsigned*)(P.ws + WS_CTL) + CW_CNT;
        const int c = lane < 32 ? (int)__hip_atomic_load(cnt + lane, __ATOMIC_RELAXED, __HIP_MEMORY_SCOPE_AGENT) : 0;
        const int nt = (c + 255) >> 8; int incl = nt;
#pragma unroll
        for (int o = 1; o < 32; o <<= 1) { const int t = __shfl_up(incl, o); if (lane >= o) incl += t; }
        const int excl = incl - nt;
        if (lane < 32) { lctl[(LC_CNT - LDSCTL_OFF) / 4 + lane] = c; lctl[(LC_TB - LDSCTL_OFF) / 4 + lane] = excl; for (int t = 0; t < nt; ++t) lctl[(LC_TEXP - LDSCTL_OFF) / 4 + excl + t] = lane; }
        if (lane == 31) lctl[(LC_TB - LDSCTL_OFF) / 4 + 32] = incl;
    }
    __syncthreads();
}
__device__ __forceinline__ void combine_phase(const Params& P, const LAS int* lctl, bool with_moe, int WID) {
    unsigned char* ws = P.ws;
    const int tid = opaque_tid(), lane = tid & 63, wave = tid >> 6;
    const int gw = blockIdx.x * NWAVES + wave, NGW = gridDim.x * NWAVES;
    float* rs3 = (float*)(ws + WS_MISC + 655360);
    for (int m = gw; m < NTOK; m += NGW) {
        f32x4* xr = (f32x4*)(P.out + (size_t)m * D) + lane; f32x4 v[8];
#pragma unroll
        for (int j = 0; j < 8; ++j) v[j] = xr[64 * j];
        if (with_moe) {
            const int* route = (const int*)(ws + WS_ROUTE) + m * 8;
            const int e1 = route[0], p1 = route[1], e2 = route[2], p2 = route[3]; const float w1 = ((const float*)route)[4], w2 = ((const float*)route)[5];
            const int r1 = lctl[(LC_TB - LDSCTL_OFF) / 4 + e1] * 256 + p1, r2 = lctl[(LC_TB - LDSCTL_OFF) / 4 + e2] * 256 + p2;
            const u32x2* y1 = (const u32x2*)((const bf16_t*)(ws + WS_Y) + (size_t)r1 * D) + lane; const u32x2* y2 = (const u32x2*)((const bf16_t*)(ws + WS_Y) + (size_t)r2 * D) + lane;
#pragma unroll
            for (int j = 0; j < 8; ++j) { const u32x2 a = y1[64 * j], b = y2[64 * j];
                v[j][0] += w1 * bflo(a.x) + w2 * bflo(b.x); v[j][1] += w1 * bfhi(a.x) + w2 * bfhi(b.x); v[j][2] += w1 * bflo(a.y) + w2 * bflo(b.y); v[j][3] += w1 * bfhi(a.y) + w2 * bfhi(b.y); }
#pragma unroll
            for (int j = 0; j < 8; ++j) xr[64 * j] = v[j];
        }
        float s = 0.f;
#pragma unroll
        for (int j = 0; j < 8; ++j) s += (v[j][0] * v[j][0] + v[j][1] * v[j][1]) + (v[j][2] * v[j][2] + v[j][3] * v[j][3]);
        const float rstd = rsqrtf(wave_sum(s) * (1.f / D) + RMS_EPS);
        if (lane == 0) rs3[m] = rstd;
        u32x2* o = (u32x2*)((bf16_t*)(ws + WS_XN) + (size_t)m * D) + lane; const f32x4* g = (const f32x4*)P.ple_norm + lane;
#pragma unroll
        for (int j = 0; j < 8; ++j) { const f32x4 gg = g[64 * j]; u32x2 w; w.x = cvt_pk_bf16(v[j][0] * gg[0], v[j][1] * gg[1]); w.y = cvt_pk_bf16(v[j][2] * gg[2], v[j][3] * gg[3]); o[64 * j] = w; }
    }
}

constexpr int HG_TS = 72;
__device__ __forceinline__ void hg_pass1(const Params& P, LAS unsigned char* lds, int ci, int WID) {
    unsigned char* ws = P.ws;
    const int tid = opaque_tid(), lane = tid & 63, wave = __builtin_amdgcn_readfirstlane(tid >> 6);
    const int bh = ci >> 5, n = ci & 31, b = bh >> 3, h = bh & 7, t0 = b * T + n * 64, c0 = h * 128;
    LAS bf16_t* KT = (LAS bf16_t*)lds;
    LAS bf16_t* VT = (LAS bf16_t*)(lds + 128 * HG_TS * 2);
    LAS float* tot = (LAS float*)(lds + 2 * 128 * HG_TS * 2);
    const int d = tid & 127, tq = tid >> 7;
    float* lf = (float*)(ws + WS_LF) + (size_t)(t0 + 16 * tq) * 1024 + c0 + d;
    float bb[16]; float run = 0.f;
#pragma unroll
    for (int j = 0; j < 16; ++j) { run += lf[(size_t)j * 1024]; bb[j] = run; }
    tot[tq * 128 + d] = run;
    __syncthreads();
    float off = 0.f, blast = 0.f;
#pragma unroll
    for (int q = 0; q < 4; ++q) { const float tv = tot[q * 128 + d]; blast += tv; if (q < tq) off += tv; }
#pragma unroll
    for (int j = 0; j < 16; ++j) { bb[j] += off; lf[(size_t)j * 1024] = bb[j]; }
    if (tq == 0) ((float*)(ws + WS_GDEC))[ci * 128 + d] = __expf(blast);
    const bf16_t* kh = (const bf16_t*)(ws + WS_KH) + (size_t)(t0 + 16 * tq) * 1024 + c0 + d;
    const bf16_t* vh = (const bf16_t*)(ws + WS_VH) + (size_t)(t0 + 16 * tq) * 1024 + c0 + d;
    unsigned kw[8], vw[8];
#pragma unroll
    for (int j = 0; j < 8; ++j) {
        const float k0 = bf2f(kh[(size_t)(2 * j) * 1024]) * __expf(blast - bb[2 * j]), k1 = bf2f(kh[(size_t)(2 * j + 1) * 1024]) * __expf(blast - bb[2 * j + 1]);
        kw[j] = cvt_pk_bf16(k0, k1);
        vw[j] = (unsigned)vh[(size_t)(2 * j) * 1024] | ((unsigned)vh[(size_t)(2 * j + 1) * 1024] << 16);
    }
    *(LAS u32x4*)(KT + d * HG_TS + 16 * tq) = (u32x4){kw[0], kw[1], kw[2], kw[3]}; *(LAS u32x4*)(KT + d * HG_TS + 16 * tq + 8) = (u32x4){kw[4], kw[5], kw[6], kw[7]};
    *(LAS u32x4*)(VT + d * HG_TS + 16 * tq) = (u32x4){vw[0], vw[1], vw[2], vw[3]}; *(LAS u32x4*)(VT + d * HG_TS + 16 * tq + 8) = (u32x4){vw[4], vw[5], vw[6], vw[7]};
    __syncthreads();
    const int r32 = lane & 31, hh = lane >> 5;
    float* U = (float*)(ws + WS_U) + (size_t)ci * 16384;
#pragma unroll
    for (int x = 0; x < 2; ++x) {
        const int tile = wave * 2 + x, dvt = tile >> 2, dkt = tile & 3;
        f32x16 acc = {};
#pragma unroll
        for (int s = 0; s < 4; ++s) {
            const bf16x8 af = *(const LAS bf16x8*)(VT + (dvt * 32 + r32) * HG_TS + 16 * s + 8 * hh);
            const bf16x8 bf = *(const LAS bf16x8*)(KT + (dkt * 32 + r32) * HG_TS + 16 * s + 8 * hh);
            acc = __builtin_amdgcn_mfma_f32_32x32x16_bf16(af, bf, acc, 0, 0, 0);
        }
#pragma unroll
        for (int i = 0; i < 16; ++i) { const int dv = dvt * 32 + (i & 3) + 8 * (i >> 2) + 4 * hh; U[dv * 128 + dkt * 32 + r32] = acc[i]; }
    }
    __syncthreads();
}
__device__ __forceinline__ void hg_scan(const Params& P, int WID) {
    unsigned char* ws = P.ws;
    const int gt = blockIdx.x * NTHR + opaque_tid(), NGT = gridDim.x * NTHR;
    for (int it = gt; it < 32 * 4096; it += NGT) {
        const int bh = it >> 12, e = (it & 4095) * 4, dk = e & 127;
        f32x4 S = {0.f, 0.f, 0.f, 0.f};
#pragma unroll 4
        for (int n = 0; n < 32; ++n) {
            const int ci = bh * 32 + n;
            u32x2 w; w.x = cvt_pk_bf16(S[0], S[1]); w.y = cvt_pk_bf16(S[2], S[3]);
            *(u32x2*)((bf16_t*)(ws + WS_ST) + (size_t)ci * 16384 + e) = w;
            const f32x4 g = *(const f32x4*)((const float*)(ws + WS_GDEC) + ci * 128 + dk);
            const f32x4 u = *(const f32x4*)((const float*)(ws + WS_U) + (size_t)ci * 16384 + e);
            S = g * S + u;
        }
    }
}
__device__ __forceinline__ void hg_pass3(const Params& P, LAS unsigned char* lds, int ci, int WID) {
    unsigned char* ws = P.ws;
    const int tid = opaque_tid(), lane = tid & 63, wave = __builtin_amdgcn_readfirstlane(tid >> 6);
    const int bh = ci >> 5, n = ci & 31, b = bh >> 3, h = bh & 7, t0 = b * T + n * 64, c0 = h * 128;
    LAS bf16_t* VT = (LAS bf16_t*)lds;
    LAS float* red = (LAS float*)(lds + 128 * HG_TS * 2);
    {
        const int d = tid & 127, tq = tid >> 7;
        const bf16_t* vh = (const bf16_t*)(ws + WS_VH) + (size_t)(t0 + 16 * tq) * 1024 + c0 + d; unsigned vw[8];
#pragma unroll
        for (int j = 0; j < 8; ++j) vw[j] = (unsigned)vh[(size_t)(2 * j) * 1024] | ((unsigned)vh[(size_t)(2 * j + 1) * 1024] << 16);
        *(LAS u32x4*)(VT + d * HG_TS + 16 * tq) = (u32x4){vw[0], vw[1], vw[2], vw[3]}; *(LAS u32x4*)(VT + d * HG_TS + 16 * tq + 8) = (u32x4){vw[4], vw[5], vw[6], vw[7]};
    }
    __syncthreads();
    const int dvt = wave & 3, tt = wave >> 2, r32 = lane & 31, hh = lane >> 5;
    const float* bc = (const float*)(ws + WS_LF);
    const bf16_t* qh = (const bf16_t*)(ws + WS_QH); const bf16_t* kh = (const bf16_t*)(ws + WS_KH);
    const size_t rowq = (size_t)(t0 + tt * 32 + r32) * 1024 + c0, rowm = (size_t)(t0 + 31) * 1024 + c0;
    bf16x8 Qs[8], Qp[8];
#pragma unroll
    for (int kk = 0; kk < 8; ++kk) {
        const int dd = 16 * kk + 8 * hh; f32x4 q0, q1; unpack8(*(const u32x4*)(qh + rowq + dd), q0, q1);
        const f32x4 b0 = *(const f32x4*)(bc + rowq + dd), b1 = *(const f32x4*)(bc + rowq + dd + 4), m0 = *(const f32x4*)(bc + rowm + dd), m1 = *(const f32x4*)(bc + rowm + dd + 4);
        f32x4 s0, s1, p0, p1;
#pragma unroll
        for (int e = 0; e < 4; ++e) { s0[e] = q0[e] * __expf(b0[e] - m0[e]); s1[e] = q1[e] * __expf(b1[e] - m1[e]); p0[e] = q0[e] * __expf(b0[e]); p1[e] = q1[e] * __expf(b1[e]); }
        Qs[kk] = __builtin_bit_cast(bf16x8, pack8(s0, s1)); Qp[kk] = __builtin_bit_cast(bf16x8, pack8(p0, p1));
    }
    f32x16 o = {};
#pragma unroll
    for (int st = 0; st < 2; ++st) {
        if (st <= tt) {
            const size_t rowk = (size_t)(t0 + st * 32 + r32) * 1024 + c0;
            f32x16 am = {};
#pragma unroll
            for (int kk = 0; kk < 8; ++kk) {
                const int dd = 16 * kk + 8 * hh; f32x4 k0, k1; unpack8(*(const u32x4*)(kh + rowk + dd), k0, k1);
                const f32x4 b0 = *(const f32x4*)(bc + rowk + dd), b1 = *(const f32x4*)(bc + rowk + dd + 4), m0 = *(const f32x4*)(bc + rowm + dd), m1 = *(const f32x4*)(bc + rowm + dd + 4);
#pragma unroll
                for (int e = 0; e < 4; ++e) { k0[e] *= __expf(m0[e] - b0[e]); k1[e] *= __expf(m1[e] - b1[e]); }
                am = __builtin_amdgcn_mfma_f32_32x32x16_bf16(__builtin_bit_cast(bf16x8, pack8(k0, k1)), Qs[kk], am, 0, 0, 0);
            }
            if (st == tt) {
#pragma unroll
                for (int i = 0; i < 16; ++i) { const int sl = (i & 3) + 8 * (i >> 2) + 4 * hh; if (sl > r32) am[i] = 0.f; }
            }
#pragma unroll
            for (int sp = 0; sp < 2; ++sp) {
                u32x4 pw; pw.x = cvt_pk_bf16(am[8 * sp + 0], am[8 * sp + 1]); pw.y = cvt_pk_bf16(am[8 * sp + 2], am[8 * sp + 3]); pw.z = cvt_pk_bf16(am[8 * sp + 4], am[8 * sp + 5]); pw.w = cvt_pk_bf16(am[8 * sp + 6], am[8 * sp + 7]);
                const LAS bf16_t* vp = VT + (dvt * 32 + r32) * HG_TS + st * 32 + 16 * sp + 4 * hh;
                const u32x2 va = *(const LAS u32x2*)vp, vb = *(const LAS u32x2*)(vp + 8);
                const u32x4 vf = (u32x4){va.x, va.y, vb.x, vb.y};
                o = __builtin_amdgcn_mfma_f32_32x32x16_bf16(__builtin_bit_cast(bf16x8, vf), __builtin_bit_cast(bf16x8, pw), o, 0, 0, 0);
            }
        }
    }
    const bf16_t* stp = (const bf16_t*)(ws + WS_ST) + (size_t)ci * 16384 + (size_t)(dvt * 32 + r32) * 128;
#pragma unroll
    for (int kk = 0; kk < 8; ++kk) {
        const bf16x8 sf = *(const bf16x8*)(stp + 16 * kk + 8 * hh);
        o = __builtin_amdgcn_mfma_f32_32x32x16_bf16(sf, Qp[kk], o, 0, 0, 0);
    }
    float ssq = 0.f;
#pragma unroll
    for (int i = 0; i < 16; ++i) ssq += o[i] * o[i];
    ssq += __shfl_xor(ssq, 32);
    if (hh == 0) red[(tt * 4 + dvt) * 32 + r32] = ssq;
    __syncthreads();
    const float tot = (red[(tt * 4 + 0) * 32 + r32] + red[(tt * 4 + 1) * 32 + r32]) + (red[(tt * 4 + 2) * 32 + r32] + red[(tt * 4 + 3) * 32 + r32]);
    const float rstd = rsqrtf(tot * (1.f / 128.f) + RMS_EPS);
    const bf16_t* hgo = (const bf16_t*)(ws + WS_HGO) + rowq; bf16_t* ohg = (bf16_t*)(ws + WS_OHG) + rowq;
#pragma unroll
    for (int g4 = 0; g4 < 4; ++g4) {
        const int dv0 = dvt * 32 + 8 * g4 + 4 * hh; const u32x2 hw = *(const u32x2*)(hgo + dv0); const f32x4 gn = *(const f32x4*)(P.hg_out_norm + dv0);
        const float v0 = o[4 * g4 + 0] * rstd * gn[0] * bflo(hw.x), v1 = o[4 * g4 + 1] * rstd * gn[1] * bfhi(hw.x), v2 = o[4 * g4 + 2] * rstd * gn[2] * bflo(hw.y), v3 = o[4 * g4 + 3] * rstd * gn[3] * bfhi(hw.y);
        u32x2 w; w.x = cvt_pk_bf16(v0, v1); w.y = cvt_pk_bf16(v2, v3); *(u32x2*)(ohg + dv0) = w;
    }
    __syncthreads();
}

__device__ __forceinline__ unsigned ord_key(float f) { const unsigned u = __float_as_uint(f); return (u & 0x80000000u) ? ~u : (u | 0x80000000u); }
constexpr int IX_SC = 0, IX_KB = 65536, IX_BUF = 128 * 128;
__device__ __forceinline__ void indexer_item(const Params& P, LAS unsigned char* lds, int item, int WID) {
    unsigned char* ws = P.ws;
    const int tid = opaque_tid(), lane = tid & 63;
    const int b = item >> 8, qg = item & 255, t0 = qg * 8;
    const int mt = WID & 3, kh = WID >> 2, tb = t0 + 2 * mt;
    LAS float* sc = (LAS float*)(lds + IX_SC);
    const int r32 = lane & 31, hh = lane >> 5;
    const bf16_t* iq = (const bf16_t*)(ws + WS_IQ); const bf16_t* ik = (const bf16_t*)(ws + WS_IK);
    const int nseg = (t0 + 8 + 127) >> 7;
    const bf16_t* sg = ik + (size_t)(b * T + WID * 16 + (lane >> 3)) * 64 + 8 * ((lane & 7) ^ ((lane >> 3) & 7));
#define IX_DMA(sgm, bo) do { _Pragma("unroll") for (int i_ = 0; i_ < 2; ++i_) \
        __builtin_amdgcn_global_load_lds((const unsigned*)(sg + (size_t)((sgm) * 128 + 8 * i_) * 64), (LAS unsigned*)(lds + IX_KB + (bo) + (WID * 2 + i_) * 1024), 16, 0, 0); } while (0)
    IX_DMA(0, 0);
    bf16x8 af[4];
    { const int qi = (r32 >> 2) & 1, hd = (r32 & 3) + 4 * (r32 >> 3); const bf16_t* ap = iq + (size_t)(b * T + tb + qi) * 1024 + hd * 64 + 8 * hh;
#pragma unroll
      for (int kk = 0; kk < 4; ++kk) af[kk] = *(const bf16x8*)(ap + 16 * kk); }
    float wq[16];
    { const f32x4* wp = (const f32x4*)((const float*)(ws + WS_IW) + (size_t)(b * T + tb + hh) * 16);
#pragma unroll
      for (int i = 0; i < 4; ++i) { const f32x4 w = wp[i]; wq[4 * i] = w[0]; wq[4 * i + 1] = w[1]; wq[4 * i + 2] = w[2]; wq[4 * i + 3] = w[3]; } }
    const int tq = tb + hh;
    int boff[4];
#pragma unroll
    for (int kk = 0; kk < 4; ++kk) boff[kk] = (kh * 64 + r32) * 128 + (((2 * kk + hh) ^ (r32 & 7)) * 16);
    asm volatile("s_waitcnt vmcnt(0)" ::: "memory");
    __syncthreads();
    for (int sgm = 0; sgm < nseg; ++sgm) {
        if (sgm + 1 < nseg) IX_DMA(sgm + 1, ((sgm + 1) & 1) * IX_BUF);
        const LAS unsigned char* bp = lds + IX_KB + (sgm & 1) * IX_BUF;
#pragma unroll
        for (int x = 0; x < 2; ++x) {
            f32x16 acc = {};
#pragma unroll
            for (int kk = 0; kk < 4; ++kk) acc = __builtin_amdgcn_mfma_f32_32x32x16_bf16(af[kk], *(const LAS bf16x8*)(bp + x * 32 * 128 + boff[kk]), acc, 0, 0, 0);
            float s = 0.f;
#pragma unroll
            for (int i = 0; i < 16; ++i) s += wq[i] * fmaxf(acc[i], 0.f);
            const int sp = sgm * 128 + (kh * 2 + x) * 32 + r32;
            sc[(2 * mt + hh) * 2048 + sp] = (sp <= tq) ? s : -INFINITY;
        }
        asm volatile("s_waitcnt vmcnt(0)" ::: "memory");
        __syncthreads();
    }
#undef IX_DMA
    unsigned* mask = (unsigned*)(ws + WS_MASK);
    {
        const int t = t0 + WID, nvalid = t + 1; unsigned wv;
        if (nvalid <= 256) {
            const int lo = lane * 32; wv = (lo + 31 <= t) ? 0xffffffffu : (lo <= t ? ((1u << (t - lo + 1)) - 1u) : 0u);
        } else {
            const int nj = (nvalid + 63) >> 6, nj8 = (nj + 7) >> 3; unsigned key[32];
#pragma unroll
            for (int j = 0; j < 32; ++j) { const int s = j * 64 + lane; key[j] = (j < nj && s <= t) ? ord_key(sc[WID * 2048 + s]) : 0u; }
            unsigned thr = 0u;
            for (int bit = 31; bit >= 0; --bit) {
                const unsigned cand = thr | (1u << bit); int cnt = 0;
#pragma unroll
                for (int j8 = 0; j8 < 4; ++j8) if (j8 < nj8) {
#pragma unroll
                    for (int j = 0; j < 8; ++j) cnt += __builtin_popcountll(__ballot(key[j8 * 8 + j] >= cand));
                }
                if (cnt >= 256) thr = cand;
            }
            int ngt = 0;
#pragma unroll
            for (int j = 0; j < 32; ++j) ngt += __builtin_popcountll(__ballot(key[j] > thr));
            int need = 256 - ngt; wv = 0u;
#pragma unroll
            for (int j = 0; j < 32; ++j) {
                unsigned long long w64 = 0ull;
                if (j < nj) {
                    const unsigned long long gt = __ballot(key[j] > thr); unsigned long long eq = __ballot(key[j] == thr);
                    int ce = __builtin_popcountll(eq);
                    if (ce > need) { unsigned long long tk = 0ull; for (int r = 0; r < need; ++r) { const unsigned long long low = eq & (0ull - eq); tk |= low; eq ^= low; } eq = tk; ce = need; }
                    need -= ce; w64 = gt | eq;
                }
                if ((lane >> 1) == j) wv = (lane & 1) ? (unsigned)(w64 >> 32) : (unsigned)w64;
            }
        }
        mask[(size_t)(b * T + t) * 64 + lane] = wv;
    }
    __syncthreads();
}

constexpr int AT_KS = 136, AT_VS = 72;
constexpr int AT_KB = 64 * AT_KS * 2, AT_VB = 128 * AT_VS * 2, AT_BUF = AT_KB + AT_VB;
__device__ __forceinline__ void attn_block(const Params& P, LAS unsigned char* lds, int b, int h, int QB, int WID) {
    unsigned char* ws = P.ws;
    const int tid = opaque_tid(), lane = tid & 63, c16 = lane & 15, g = lane >> 4;
    const bf16_t* aq = (const bf16_t*)(ws + WS_AQ); const bf16_t* ak = (const bf16_t*)(ws + WS_AK); const bf16_t* vt = (const bf16_t*)(ws + WS_VT);
    const unsigned* mask = (const unsigned*)(ws + WS_MASK);
    const int q0 = QB * 128 + WID * 16, t = q0 + c16; const size_t tokq = (size_t)b * T + t;
    const int ntile = 2 * QB + 2;
    const int mytiles = (q0 + 15) / 64 + 1;
    const int kr0 = tid >> 4, kc = tid & 15, vr0 = tid >> 3, vc = tid & 7;
    const bf16_t* kg = ak + ((size_t)b * T + kr0) * 1024 + h * 128 + 8 * kc;
    const bf16_t* vg = vt + (size_t)(h * 128 + vr0) * NTOK + (size_t)b * T + 8 * vc;
    const int klo = (kr0 * AT_KS + 8 * kc) * 2, vlo = AT_KB + (vr0 * AT_VS + 8 * vc) * 2;
    u32x4 sk0, sk1, sv0, sv1;
#define AT_LOAD(tt) do { sk0 = *(const u32x4*)(kg + (size_t)(tt) * 64 * 1024); sk1 = *(const u32x4*)(kg + (size_t)((tt) * 64 + 32) * 1024); \
                         sv0 = *(const u32x4*)(vg + (tt) * 64); sv1 = *(const u32x4*)(vg + (size_t)64 * NTOK + (tt) * 64); } while (0)
#define AT_STORE(bufo) do { *(LAS u32x4*)(lds + (bufo) + klo) = sk0; *(LAS u32x4*)(lds + (bufo) + klo + 32 * AT_KS * 2) = sk1; \
                            *(LAS u32x4*)(lds + (bufo) + vlo) = sv0; *(LAS u32x4*)(lds + (bufo) + vlo + 64 * AT_VS * 2) = sv1; } while (0)
    AT_LOAD(0);
    bf16x8 qf[4];
#pragma unroll
    for (int kk = 0; kk < 4; ++kk) qf[kk] = *(const bf16x8*)(aq + tokq * 1024 + h * 128 + 32 * kk + 8 * g);
    const float slope2 = exp2f(-(float)(h + 1)) * 1.4426950408889634f;
    float m = -1e30f, lsum = 0.f;
    f32x4 o[8];
#pragma unroll
    for (int dt = 0; dt < 8; ++dt) o[dt] = (f32x4){0.f, 0.f, 0.f, 0.f};
    const unsigned* mrow = mask + tokq * 64;
    AT_STORE(0);
    __syncthreads();
    for (int tt = 0; tt < ntile; ++tt) {
        const int bufo = (tt & 1) * AT_BUF;
        if (tt + 1 < ntile) AT_LOAD(tt + 1);
        if (tt < mytiles) {
            const int k0 = tt * 64;
            const unsigned mw0 = mrow[2 * tt], mw1 = mrow[2 * tt + 1];
            f32x4 cs[4];
#pragma unroll
            for (int sb = 0; sb < 4; ++sb) {
                const LAS unsigned char* kp = lds + bufo + ((sb * 16 + c16) * AT_KS + 8 * g) * 2;
                f32x4 cc = {0.f, 0.f, 0.f, 0.f};
#pragma unroll
                for (int kk = 0; kk < 4; ++kk) cc = __builtin_amdgcn_mfma_f32_16x16x32_bf16(*(const LAS bf16x8*)(kp + 64 * kk), qf[kk], cc, 0, 0, 0);
                cs[sb] = cc;
            }
            float p[16]; float mx = -INFINITY;
#pragma unroll
            for (int sb = 0; sb < 4; ++sb)
#pragma unroll
                for (int i = 0; i < 4; ++i) {
                    const int s = k0 + sb * 16 + 4 * g + i; const unsigned mw = (sb < 2) ? mw0 : mw1;
                    const float v = ((mw >> ((sb & 1) * 16 + 4 * g + i)) & 1u) ? cs[sb][i] - slope2 * (float)(t - s) : -INFINITY;
                    p[sb * 4 + i] = v; mx = fmaxf(mx, v);
                }
            mx = fmaxf(mx, __shfl_xor(mx, 16)); mx = fmaxf(mx, __shfl_xor(mx, 32));
            const float mn = fmaxf(m, mx), alpha = __builtin_amdgcn_exp2f(m - mn); m = mn;
            float rs = 0.f;
#pragma unroll
            for (int i = 0; i < 16; ++i) { p[i] = __builtin_amdgcn_exp2f(p[i] - mn); rs += p[i]; }
            lsum = lsum * alpha + rs;
#pragma unroll
            for (int dt = 0; dt < 8; ++dt) o[dt] = o[dt] * alpha;
            bf16x8 pf[2];
#pragma unroll
            for (int kh = 0; kh < 2; ++kh) { u32x4 pw; pw.x = cvt_pk_bf16(p[8 * kh + 0], p[8 * kh + 1]); pw.y = cvt_pk_bf16(p[8 * kh + 2], p[8 * kh + 3]); pw.z = cvt_pk_bf16(p[8 * kh + 4], p[8 * kh + 5]); pw.w = cvt_pk_bf16(p[8 * kh + 6], p[8 * kh + 7]); pf[kh] = __builtin_bit_cast(bf16x8, pw); }
#pragma unroll
            for (int dt = 0; dt < 8; ++dt) {
                const LAS unsigned char* vp = lds + bufo + AT_KB + ((16 * dt + c16) * AT_VS + 4 * g) * 2;
#pragma unroll
                for (int kh = 0; kh < 2; ++kh) {
                    const u32x2 va = *(const LAS u32x2*)(vp + 64 * kh), vb = *(const LAS u32x2*)(vp + 64 * kh + 32);
                    const u32x4 vf = (u32x4){va.x, va.y, vb.x, vb.y};
                    o[dt] = __builtin_amdgcn_mfma_f32_16x16x32_bf16(__builtin_bit_cast(bf16x8, vf), pf[kh], o[dt], 0, 0, 0);
                }
            }
        }
        if (tt + 1 < ntile) AT_STORE(((tt + 1) & 1) * AT_BUF);
        __syncthreads();
    }
#undef AT_LOAD
#undef AT_STORE
    lsum += __shfl_xor(lsum, 16); lsum += __shfl_xor(lsum, 32);
    const float inv = 1.f / lsum;
    bf16_t* op = (bf16_t*)(ws + WS_OAT) + tokq * 1024 + h * 128 + 4 * g;
#pragma unroll
    for (int dt = 0; dt < 8; ++dt) { u32x2 w; w.x = cvt_pk_bf16(o[dt][0] * inv, o[dt][1] * inv); w.y = cvt_pk_bf16(o[dt][2] * inv, o[dt][3] * inv); *(u32x2*)(op + 16 * dt) = w; }
}
#ifndef DO_MIXER
#define DO_MIXER 1
#endif
#ifndef DO_ATTN
#define DO_ATTN 1
#endif
#ifndef DO_HG
#define DO_HG 1
#endif
#ifndef DO_MOE
#define DO_MOE 1
#endif
#ifndef DO_PLE
#define DO_PLE 1
#endif
constexpr int NPHASE = 13;
#ifndef PROBE_ID
#define PROBE_ID -1
#endif
#define PB(id) do { if (PROBE_ID == (id)) tp0 = __builtin_amdgcn_s_memrealtime(); } while (0)
#define PE(id) do { if (PROBE_ID == (id)) tp1 = __builtin_amdgcn_s_memrealtime(); } while (0)

__global__ void __launch_bounds__(NTHR, 2) fwd_kernel(Params P) {
    extern __shared__ __attribute__((aligned(16))) unsigned char lds_raw[];
    LAS unsigned char* lds = (LAS unsigned char*)lds_raw;
    LAS int* lctl = (LAS int*)(lds + LDSCTL_OFF);
    const int WID = __builtin_amdgcn_readfirstlane((int)threadIdx.x >> 6);
    for (int u = opaque_tid(); u < (LDS_BYTES - LDSCTL_OFF) / 4; u += NTHR) ((LAS unsigned*)(lds + LDSCTL_OFF))[u] = 0u;
    __syncthreads();
    unsigned* ctl = (unsigned*)(P.ws + WS_CTL);
    XcdBarrier bar; bar.bar = ctl + CW_BAR; bar.x = 0; bar.st = nullptr; bar.wid = WID;
    const bool one_launch = (P.ph_hi - P.ph_lo) > 1;
    if (one_launch) bar = xcd_barrier_post(ctl + CW_BAR, (volatile LAS unsigned*)(lds + LC_MISC) + 8, WID);
    const int lo = P.ph_lo, hi = P.ph_hi;
#define IN(k) (lo <= (k) && (k) < hi)
#define SEAM(k) do { if (IN(k) && IN((k) + 1)) xcd_barrier(bar); } while (0)
    const int c = blockIdx.x, G = gridDim.x;
    unsigned long long tp0 = 0, tp1 = 0;

    PB(0); if (IN(0)) { prologue_phase(P, lds, WID); }
    SEAM(0); PE(0);
    PB(1); if (IN(1)) {
#if DO_MIXER
        gemm_phase<GP_INPROJ, false>(P, lds, lctl, WID);
#endif
#if DO_PLE
        gemm_phase<GP_PP, false>(P, lds, lctl, WID);
#endif
    }
    SEAM(1); PE(1);
    if (IN(2)) {
#if DO_MIXER
#if DO_ATTN
        PB(2); for (int k = 0; k < 4; ++k) { const int item = (k >> 1) * 512 + ((k & 1) ? 511 - c : c); if (c < 256) indexer_item(P, lds, item, WID); }
        __syncthreads(); PE(2);
#endif
#if DO_HG
        PB(3); for (int ci = c; ci < 1024; ci += G) hg_pass1(P, lds, ci, WID); PE(3);
#endif
#endif
    }
    SEAM(2);
    if (IN(3)) {
#if DO_MIXER && DO_HG
        PB(4); hg_scan(P, WID); PE(4);
#endif
    }
    SEAM(3);
    if (IN(4)) {
#if DO_MIXER
#if DO_ATTN
        PB(5); for (int it = c; it < 256; it += G) { const int bh = it >> 3, j = it & 7; attn_block(P, lds, bh >> 3, bh & 7, j, WID); attn_block(P, lds, bh >> 3, bh & 7, 15 - j, WID); }
        __syncthreads(); PE(5);
#endif
#if DO_HG
        PB(6); for (int ci = c; ci < 1024; ci += G) hg_pass3(P, lds, ci, WID); PE(6);
#endif
#endif
    }
    SEAM(4);
    if (IN(5)) {
#if DO_MIXER
        PB(7); gemm_phase<GP_MIX, false>(P, lds, lctl, WID); PE(7);
#endif
    }
    SEAM(5);
    if (IN(6)) {
#if DO_MIXER
        PB(8); gemm_phase<GP_OUT, false>(P, lds, lctl, WID); PE(8);
#else
        copy_x_phase(P, WID);
#endif
#if DO_MOE
        __syncthreads();
        PB(9); expert_convert_phase(P, lds, WID); PE(9);
#endif
    }
    SEAM(6);
    if (IN(7)) {
#if DO_MOE
        PB(10); router_phase(P, lds, WID); PE(10);
#endif
    }
    SEAM(7);
    if (IN(8)) {
#if DO_MOE
        PB(11); moe_tables(P, lctl, WID); gemm_phase<GP_GU, true>(P, lds, lctl, WID); PE(11);
#endif
    }
    SEAM(8);
    if (IN(9)) {
#if DO_MOE
        PB(12); moe_tables(P, lctl, WID); gemm_phase<GP_DN, false>(P, lds, lctl, WID); PE(12);
#endif
    }
    SEAM(9);
    if (IN(10)) {
#if DO_MOE
        moe_tables(P, lctl, WID);
#endif
        PB(13); combine_phase(P, lctl, DO_MOE != 0, WID); PE(13);
    }
    SEAM(10);
    if (IN(11)) {
#if DO_PLE
        PB(14); gemm_phase<GP_PLE, false>(P, lds, lctl, WID); PE(14);
#endif
    }
    SEAM(11);
    PB(15); if (IN(12)) { final_norm_phase(P, WID); } PE(15);
    if (PROBE_ID >= 0) { const unsigned long long t0 = __builtin_amdgcn_s_memrealtime(), d = tp1 - tp0; while (__builtin_amdgcn_s_memrealtime() - t0 < d) __builtin_amdgcn_s_sleep(8); }
#undef IN
#undef SEAM
}

extern "C" void kernel_launch(void* const* d_in, const int* in_sizes, int n_in, void* d_out, int out_size, void* d_ws, size_t ws_size, hipStream_t stream) {
    static int grid = 0;
    if (grid == 0) {
        if (n_in != 22 || out_size != NTOK * D || ws_size < WS_NEED) { fprintf(stderr, "kernel_launch: unexpected shapes (n_in %d out %d ws %zu need %zu)\n", n_in, out_size, ws_size, (size_t)WS_NEED); grid = -1; return; }
        int dev = 0, cus = 0, per_cu = 0;
        if (hipGetDevice(&dev) != hipSuccess || hipDeviceGetAttribute(&cus, hipDeviceAttributeMultiprocessorCount, dev) != hipSuccess) { grid = -1; return; }
        if (hipFuncSetAttribute((const void*)fwd_kernel, hipFuncAttributeMaxDynamicSharedMemorySize, LDS_BYTES) != hipSuccess) { fprintf(stderr, "kernel_launch: hipFuncSetAttribute failed\n"); grid = -1; return; }
        if (hipOccupancyMaxActiveBlocksPerMultiprocessor(&per_cu, (const void*)fwd_kernel, NTHR, LDS_BYTES) != hipSuccess || per_cu < 1) fprintf(stderr, "kernel_launch: occupancy query reports %d\n", per_cu);
        (void)hipGetLastError();
        grid = cus;
    }
    if (grid < 0) return;
    (void)hipMemsetAsync((char*)d_ws + WS_CTL, 0, CTL_ZERO_BYTES, stream);
    Params p{};
    const float** f = (const float**)&p;
    for (int i = 0; i < 22; ++i) f[i] = (const float*)d_in[i];
    p.out = (float*)d_out; p.ws = (unsigned char*)d_ws;
#if N_LAUNCH_MODE == 1
    p.ph_lo = 0; p.ph_hi = NPHASE;
    hipLaunchKernelGGL(fwd_kernel, dim3(grid), dim3(NTHR), LDS_BYTES, stream, p);
#else
    for (int ph = 0; ph < NPHASE; ++ph) { p.ph_lo = ph; p.ph_hi = ph + 1; hipLaunchKernelGGL(fwd_kernel, dim3(grid), dim3(NTHR), LDS_BYTES, stream, p); }
#endif
}
```
